# Optimizing an MI355X kernel written in HIP

```python
import jax
import jax.numpy as jnp
from jax import lax
import numpy as np

D_MODEL = 2048
BATCH = 1
SEQ = 16384
DEPTH = 4
DEC_BATCH = 4
DEC_SEQ = 2048
PAST_LEN = 128

D_MIX = D_MODEL
CONV_W = D_MIX // 2
CONV_GROUPS = 8
CONV_K = 3
MLSTM_W = D_MIX - CONV_W
MLSTM_HEADS = 4
MLSTM_DH = MLSTM_W // MLSTM_HEADS
CHUNK = 128
N_GATES = 4 * MLSTM_HEADS
N_IN = 3 * CONV_W + 4 * MLSTM_W + N_GATES
D_FF = (11 * D_MODEL) // 4
FFN_CONV_K = 3
EPS = 1e-6

kernel_name = 'hybrid_shortconv_mlstm_bidir_encoder'


def _rmsnorm(x, g):
    xf = x.astype(jnp.float32)
    y = xf * lax.rsqrt(jnp.mean(xf * xf, axis=-1, keepdims=True) + EPS)
    return (y * g.astype(jnp.float32)).astype(x.dtype)


def _group_rmsnorm(x, g, n_groups):
    shp = x.shape
    xf = x.astype(jnp.float32).reshape(shp[:-1] + (n_groups, shp[-1] // n_groups))
    xf = xf * lax.rsqrt(jnp.mean(xf * xf, axis=-1, keepdims=True) + EPS)
    return xf.reshape(shp) * g.astype(jnp.float32)


def _dwconv_centred(x, w):
    k_w = w.shape[0]
    s = x.shape[1]
    half = k_w // 2
    xp = jnp.pad(x, ((0, 0), (half, half), (0, 0)))
    w = w.astype(x.dtype)
    y = w[0] * xp[:, 0:s]
    for k in range(1, k_w):
        y = y + w[k] * xp[:, k:k + s]
    return y


def _mlstm_scan(q, k, v, i_pre, logf):
    b, h, s, dh = q.shape
    nc = s // CHUNK

    def to_chunks(t):
        t = t.reshape((b, h, nc, CHUNK) + t.shape[3:])
        return jnp.moveaxis(t, 2, 0)

    xs = (to_chunks(q), to_chunks(k), to_chunks(v), to_chunks(i_pre), to_chunks(logf))
    mask = jnp.tril(jnp.ones((CHUNK, CHUNK), dtype=bool))

    def step(carry, inp):
        c_s, n_s, m_s = carry
        qc, kc, vc, ic, lfc = inp
        bcum = jnp.cumsum(lfc, axis=-1)
        d_mat = bcum[..., :, None] - bcum[..., None, :] + ic[..., None, :]
        d_mat = jnp.where(mask, d_mat, -jnp.inf)
        inter = bcum + m_s[..., None]
        m_t = jnp.maximum(inter, jnp.max(d_mat, axis=-1))
        w_ts = jnp.exp(d_mat - m_t[..., None])
        scores = jnp.einsum('bhtd,bhsd->bhts', qc, kc) * w_ts
        a_t = jnp.exp(inter - m_t)
        num = a_t[..., None] * jnp.einsum('bhtd,bhde->bhte', qc, c_s) + jnp.einsum('bhts,bhse->bhte', scores, vc)
        den = a_t * jnp.einsum('bhtd,bhd->bht', qc, n_s) + jnp.sum(scores, axis=-1)
        h_out = num / jnp.maximum(jnp.abs(den), jnp.exp(-m_t))[..., None]
        b_last = bcum[..., -1]
        g_s = b_last[..., None] - bcum + ic
        m_new = jnp.maximum(b_last + m_s, jnp.max(g_s, axis=-1))
        a_c = jnp.exp(b_last + m_s - m_new)
        kw = kc * jnp.exp(g_s - m_new[..., None])[..., None]
        c_new = a_c[..., None, None] * c_s + jnp.einsum('bhsd,bhse->bhde', kw, vc)
        n_new = a_c[..., None] * n_s + jnp.sum(kw, axis=2)
        return (c_new, n_new, m_new), h_out

    init = (jnp.zeros((b, h, dh, dh), jnp.float32),
            jnp.zeros((b, h, dh), jnp.float32),
            jnp.zeros((b, h), jnp.float32))
    _, hs = lax.scan(step, init, xs)
    return jnp.moveaxis(hs, 0, 2).reshape(b, h, s, dh)


def _mixer(xn, w_in, gate_b, conv_w, conv_norm_g, mlstm_norm_g, w_out):
    b, s, _ = xn.shape
    proj = jnp.einsum('bsd,dn->bsn', xn, w_in.astype(xn.dtype))
    splits = np.cumsum([CONV_W] * 3 + [MLSTM_W] * 4).tolist()
    cb, cc, ch, q, k, v, o, gates = jnp.split(proj, splits, axis=-1)

    y_conv = cb * _dwconv_centred(cc * ch, conv_w)
    conv_out = _group_rmsnorm(y_conv, conv_norm_g, CONV_GROUPS)

    def heads(t):
        return t.reshape(b, s, MLSTM_HEADS, MLSTM_DH).transpose(0, 2, 1, 3).astype(jnp.float32)

    qh = heads(q) * (MLSTM_DH ** -0.5)
    kh = heads(k)
    vh = heads(v)
    g = (gates.astype(jnp.float32) + gate_b.astype(jnp.float32))
    g = g.reshape(b, s, 4, MLSTM_HEADS).transpose(2, 0, 3, 1)
    h_fwd = _mlstm_scan(qh, kh, vh, g[0], jax.nn.log_sigmoid(g[1]))

    def flip(t):
        return jnp.flip(t, axis=2)

    h_bwd = flip(_mlstm_scan(flip(qh), flip(kh), flip(vh), flip(g[2]), jax.nn.log_sigmoid(flip(g[3]))))
    hm = (h_fwd + h_bwd).transpose(0, 2, 1, 3).reshape(b, s, MLSTM_W)
    hm = _group_rmsnorm(hm, mlstm_norm_g, MLSTM_HEADS) * jax.nn.sigmoid(o.astype(jnp.float32))

    mixed = jnp.concatenate([conv_out, hm], axis=-1).astype(xn.dtype)
    return jnp.einsum('bsm,md->bsd', mixed, w_out.astype(xn.dtype))


def _conv_glu_ffn(xn, w_up, ffn_conv_w, ffn_conv_b, w_down):
    u = jnp.einsum('bsd,df->bsf', xn, w_up.astype(xn.dtype))
    u = _dwconv_centred(u, ffn_conv_w) + ffn_conv_b.astype(u.dtype)
    u_g, u_v = jnp.split(u, 2, axis=-1)
    return jnp.einsum('bsf,fd->bsd', jax.nn.silu(u_g) * u_v, w_down.astype(xn.dtype))


def _trunk(x, norm_mix_g, w_in, gate_b, conv_w, conv_norm_g, mlstm_norm_g, w_out,
           norm_ffn_g, w_up, ffn_conv_w, ffn_conv_b, w_down, final_norm_g):
    for l in range(DEPTH):
        x = x + _mixer(_rmsnorm(x, norm_mix_g[l]), w_in[l], gate_b[l], conv_w[l],
                       conv_norm_g[l], mlstm_norm_g[l], w_out[l])
        x = x + _conv_glu_ffn(_rmsnorm(x, norm_ffn_g[l]), w_up[l], ffn_conv_w[l],
                              ffn_conv_b[l], w_down[l])
    return _rmsnorm(x, final_norm_g)


def setup_inputs(seed: int = 0) -> dict:
    key = jax.random.key(seed)
    ks = jax.random.split(key, 16)
    f32 = jnp.float32

    def nrm(k, shape, scale):
        return jax.random.normal(k, shape, f32) * scale

    res_scale = (2 * DEPTH) ** -0.5
    x_prompt = nrm(ks[0], (BATCH, SEQ, D_MODEL), 1.0)
    x_sample = nrm(ks[1], (DEC_BATCH, DEC_SEQ, D_MODEL), 1.0)
    norm_mix_g = 1.0 + nrm(ks[2], (DEPTH, D_MODEL), 0.02)
    w_in = nrm(ks[3], (DEPTH, D_MODEL, N_IN), D_MODEL ** -0.5)
    f_bias = jnp.linspace(3.0, 6.0, MLSTM_HEADS, dtype=f32)
    zeros_h = jnp.zeros((MLSTM_HEADS,), f32)
    base_gb = jnp.stack([zeros_h, f_bias, zeros_h, f_bias])
    gate_b = (nrm(ks[4], (DEPTH, 4, MLSTM_HEADS), 0.1) + base_gb[None]).reshape(DEPTH, N_GATES)
    conv_w = nrm(ks[5], (DEPTH, CONV_K, CONV_W), CONV_K ** -0.5)
    conv_norm_g = 1.0 + nrm(ks[6], (DEPTH, CONV_W), 0.02)
    mlstm_norm_g = 1.0 + nrm(ks[7], (DEPTH, MLSTM_W), 0.02)
    w_out = nrm(ks[8], (DEPTH, D_MIX, D_MODEL), (D_MIX ** -0.5) * res_scale)
    norm_ffn_g = 1.0 + nrm(ks[9], (DEPTH, D_MODEL), 0.02)
    w_up = nrm(ks[10], (DEPTH, D_MODEL, 2 * D_FF), D_MODEL ** -0.5)
    ffn_conv_w = nrm(ks[11], (DEPTH, FFN_CONV_K, 2 * D_FF), FFN_CONV_K ** -0.5)
    ffn_conv_b = nrm(ks[12], (DEPTH, 2 * D_FF), 0.02)
    w_down = nrm(ks[13], (DEPTH, D_FF, D_MODEL), (D_FF ** -0.5) * res_scale)
    final_norm_g = 1.0 + nrm(ks[14], (D_MODEL,), 0.02)
    return {'x_prompt': x_prompt, 'x_sample': x_sample, 'norm_mix_g': norm_mix_g, 'w_in': w_in,
            'gate_b': gate_b, 'conv_w': conv_w, 'conv_norm_g': conv_norm_g,
            'mlstm_norm_g': mlstm_norm_g, 'w_out': w_out, 'norm_ffn_g': norm_ffn_g, 'w_up': w_up,
            'ffn_conv_w': ffn_conv_w, 'ffn_conv_b': ffn_conv_b, 'w_down': w_down,
            'final_norm_g': final_norm_g}


def reference(x_prompt, x_sample, norm_mix_g, w_in, gate_b, conv_w, conv_norm_g, mlstm_norm_g,
              w_out, norm_ffn_g, w_up, ffn_conv_w, ffn_conv_b, w_down, final_norm_g):
    y_prompt = _trunk(x_prompt, norm_mix_g, w_in, gate_b, conv_w, conv_norm_g, mlstm_norm_g,
                      w_out, norm_ffn_g, w_up, ffn_conv_w, ffn_conv_b, w_down, final_norm_g)
    y_sample = _trunk(x_sample, norm_mix_g, w_in, gate_b, conv_w, conv_norm_g, mlstm_norm_g,
                      w_out, norm_ffn_g, w_up, ffn_conv_w, ffn_conv_b, w_down, final_norm_g)
    return (y_prompt, y_sample)
```

```cpp
#include <hip/hip_runtime.h>
#include <cstdio>
#include <cstdint>
namespace pg8 {
#define PG8_LAS __attribute__((address_space(3)))
typedef unsigned short bf16_t;
typedef short bf16x8 __attribute__((ext_vector_type(8)));
typedef float f32x4 __attribute__((ext_vector_type(4)));
typedef unsigned u32x4 __attribute__((ext_vector_type(4)));
constexpr int BM = 256, BK = 64, HALF = 128, HTB = HALF * BK * 2  , STAGE_BYTES = 8 * HTB, NXCD = 8, WGM = 8;

__host__ __device__ __forceinline__ int lds_byte(int r, int c) { const int st = (r >> 4) * 2 + (c >> 5), rr = r & 15, cc = c & 31, ob = rr * 64 + cc * 2; return st * 1024 + (ob ^ (((ob >> 9) & 1) << 5)); }
__host__ __device__ __forceinline__ void stage_rc(int b, int& R, int& C) { const int st = b / 1024, sb = b % 1024, swz = sb ^ (((sb >> 9) & 1) << 5); R = (st >> 1) * 16 + swz / 64; C = (st & 1) * 32 + (swz % 64) / 2; }
__host__ __device__ __forceinline__ int perm32(int rho) { const int n = rho >> 4, i = rho & 15; return 8 * (i >> 2) + 4 * n + (i & 3); }

struct Unit { int pm, pn; };
struct Gemm { const bf16_t* A; const bf16_t* Bt; int M, N, K; };

struct StaticOrder {
    int nM, nN, nwg, G, c;
    __host__ __device__ void init(int M, int N, int G_, int c_) { nM = M / BM; nN = N / BM; nwg = nM * nN; G = G_; c = c_; }
    __host__ __device__ bool next(int i, Unit& u) const {
        const long L = (long)i * G + c; if (L >= nwg) return false;
        int wgid = (int)L; { const int q = nwg / NXCD, r = nwg % NXCD, xcd = wgid % NXCD, off = wgid / NXCD; wgid = (xcd < r ? xcd * (q + 1) : r * (q + 1) + (xcd - r) * q) + off; }
        const int nig = WGM * nN, gid = wgid / nig, fm = gid * WGM, gsz = (nM - fm) < WGM ? (nM - fm) : WGM;
        u.pm = fm + ((wgid % nig) % gsz); u.pn = (wgid % nig) / gsz; return true;
    }
    __device__ __forceinline__ void a_ready(const Unit&) const {}
    __device__ __forceinline__ void done(const Unit&) const {}
};

__device__ __forceinline__ unsigned cvt_pk_bf16(float lo, float hi) { unsigned r; asm volatile("v_cvt_pk_bf16_f32 %0, %1, %2" : "=v"(r) : "v"(lo), "v"(hi)); return r; }
typedef float f32x2 __attribute__((ext_vector_type(2)));
typedef unsigned u32x2 __attribute__((ext_vector_type(2)));
constexpr float RMS_EPS = 1e-6f;
__device__ __forceinline__ unsigned long long ss_fix(float ss) { return (unsigned long long)(ss * 1048576.0f); }
__device__ __forceinline__ float rstd_of(unsigned long long q) { return rsqrtf((float)q * (1.0f / (1048576.0f * 2048.0f)) + RMS_EPS); }
struct EpiProj {
    static constexpr bool PERM = true, AFTER_DRAIN = false;
    bf16_t* P; float* gates; const unsigned long long* sumsq; const float* gate_b;
    __device__ __forceinline__ void operator()(const f32x4 (&acc)[2][2][4][2], const Unit& u, int wr, int wc, int fr, int fq) const {
        const int row0 = u.pm * BM + wr * 64 + fr;
        if (u.pn < 28) {
            const int col0 = u.pn * BM + wc * 32 + 8 * fq;
#pragma unroll
            for (int ai = 0; ai < 2; ++ai)
#pragma unroll
                for (int m = 0; m < 4; ++m) { const int r = row0 + ai * HALF + m * 16; const float rs = rstd_of(sumsq[r]);
                    bf16_t* rowp = P + (size_t)r * 7168 + col0;
#pragma unroll
                    for (int bj = 0; bj < 2; ++bj) { const f32x4 v0 = acc[ai][bj][m][0] * rs, v1 = acc[ai][bj][m][1] * rs;
                        u32x4 w; w.x = cvt_pk_bf16(v0[0], v0[1]); w.y = cvt_pk_bf16(v0[2], v0[3]); w.z = cvt_pk_bf16(v1[0], v1[1]); w.w = cvt_pk_bf16(v1[2], v1[3]);
                        *(u32x4*)(rowp + bj * HALF) = w; } }
        } else if (wc == 0 && fq < 2) {
            const f32x4 b0 = *(const f32x4*)(gate_b + 8 * fq), b1 = *(const f32x4*)(gate_b + 8 * fq + 4);
#pragma unroll
            for (int ai = 0; ai < 2; ++ai)
#pragma unroll
                for (int m = 0; m < 4; ++m) { const int r = row0 + ai * HALF + m * 16; const float rs = rstd_of(sumsq[r]);
                    float* gp = gates + (size_t)r * 16 + 8 * fq;
                    *(f32x4*)(gp) = acc[ai][0][m][0] * rs + b0; *(f32x4*)(gp + 4) = acc[ai][0][m][1] * rs + b1; }
        }
    }
};
struct EpiScaleBf16 {
    static constexpr bool PERM = true, AFTER_DRAIN = false;
    bf16_t* O; int ldc; const unsigned long long* sumsq;
    __device__ __forceinline__ void operator()(const f32x4 (&acc)[2][2][4][2], const Unit& u, int wr, int wc, int fr, int fq) const {
        const int row0 = u.pm * BM + wr * 64 + fr, col0 = u.pn * BM + wc * 32 + 8 * fq;
#pragma unroll
        for (int ai = 0; ai < 2; ++ai)
#pragma unroll
            for (int m = 0; m < 4; ++m) { const int r = row0 + ai * HALF + m * 16; const float rs = rstd_of(sumsq[r]);
                bf16_t* rowp = O + (size_t)r * ldc + col0;
#pragma unroll
                for (int bj = 0; bj < 2; ++bj) { const f32x4 v0 = acc[ai][bj][m][0] * rs, v1 = acc[ai][bj][m][1] * rs;
                    u32x4 w; w.x = cvt_pk_bf16(v0[0], v0[1]); w.y = cvt_pk_bf16(v0[2], v0[3]); w.z = cvt_pk_bf16(v1[0], v1[1]); w.w = cvt_pk_bf16(v1[2], v1[3]);
                    *(u32x4*)(rowp + bj * HALF) = w; } }
    }
};
struct EpiResid {
    static constexpr bool PERM = false, AFTER_DRAIN = false;
    float* x; bf16_t* xb; unsigned long long* sumsq;
    __device__ __forceinline__ void operator()(const f32x4 (&acc)[2][2][4][2], const Unit& u, int wr, int wc, int fr, int fq) const {
        const int row0 = u.pm * BM + wr * 64 + fr, col0 = u.pn * BM + wc * 32 + 4 * fq;
#pragma unroll
        for (int ai = 0; ai < 2; ++ai)
#pragma unroll
            for (int m = 0; m < 4; ++m) { const int r = row0 + ai * HALF + m * 16; const size_t off = (size_t)r * 2048 + col0; float ss = 0.f;
#pragma unroll
                for (int bj = 0; bj < 2; ++bj)
#pragma unroll
                    for (int n = 0; n < 2; ++n) { float* p = x + off + bj * HALF + n * 16; const f32x4 v = *(const f32x4*)p + acc[ai][bj][m][n]; *(f32x4*)p = v;
                        ss += (v[0] * v[0] + v[1] * v[1]) + (v[2] * v[2] + v[3] * v[3]);
                        u32x2 w; w.x = cvt_pk_bf16(v[0], v[1]); w.y = cvt_pk_bf16(v[2], v[3]); *(u32x2*)(xb + off + bj * HALF + n * 16) = w; }
                ss += __shfl_xor(ss, 16); ss += __shfl_xor(ss, 32);
                if (fq == 0) __hip_atomic_fetch_add(sumsq + r, ss_fix(ss), __ATOMIC_RELAXED, __HIP_MEMORY_SCOPE_AGENT);
                asm volatile("" ::: "memory"); }
    }
};
template <class Epi, class Sched, bool ALIGN_EPI = false, bool SP2 = false>
__device__ __forceinline__ void gemm_phase(PG8_LAS unsigned char* lds, const Gemm g, const Sched& S, const Epi& E) {
    int tid = threadIdx.x; asm volatile("" : "+v"(tid));
    const int wid = __builtin_amdgcn_readfirstlane(tid >> 6), lane = tid & 63, wr = wid >> 2, wc = wid & 3, fr = lane & 15, fq = lane >> 4;
    const int K = g.K, nt = K / BK;
    unsigned voffA[2], voffB[2];
#pragma unroll
    for (int i = 0; i < 2; ++i) { int R, C; stage_rc(tid * 16 + i * 8192, R, C); const int Rb = Epi::PERM ? ((R & ~31) + perm32(R & 31)) : R;
        voffA[i] = (unsigned)(R * K + C) * 2u; voffB[i] = (unsigned)(Rb * K + C) * 2u; }
    const size_t kstep = (size_t)(BK * 2);
    const size_t hstep = (size_t)HALF * K * 2;
    const size_t tstep = 2 * hstep;
    const unsigned ldsw = (unsigned)wid * 1024u;
    const int aoff = lds_byte(wr * 64 + fr, fq * 8), boff = lds_byte(wc * 32 + fr, fq * 8);
#define PG8_SA(b, h) (((b) * 2 + (h)) * HTB)
#define PG8_SB(b, h) ((4 + (b) * 2 + (h)) * HTB)
#define PG8_STAGE(bufoff, gbase, voff) do { _Pragma("unroll") for (int _i = 0; _i < 2; ++_i) \
        __builtin_amdgcn_global_load_lds((const unsigned*)((const char*)(gbase) + (voff)[_i]), (PG8_LAS unsigned*)(lds + (bufoff) + ldsw + _i * 8192), 16, 0, 0); } while (0)
#define PG8_LDA(dst, b, h) do { _Pragma("unroll") for (int m = 0; m < 4; ++m) _Pragma("unroll") for (int k = 0; k < 2; ++k) dst[m][k] = *(const PG8_LAS bf16x8*)(lds + PG8_SA(b, h) + aoff + m * 2048 + k * 1024); } while (0)
#define PG8_LDB(dst, b, h) do { _Pragma("unroll") for (int n = 0; n < 2; ++n) _Pragma("unroll") for (int k = 0; k < 2; ++k) dst[n][k] = *(const PG8_LAS bf16x8*)(lds + PG8_SB(b, h) + boff + n * 2048 + k * 1024); } while (0)
#define PG8_MMA(ai, bj, At, Bt) do { __builtin_amdgcn_s_setprio(1); _Pragma("unroll") for (int m = 0; m < 4; ++m) _Pragma("unroll") for (int n = 0; n < 2; ++n) _Pragma("unroll") for (int k = 0; k < 2; ++k) \
        acc[ai][bj][m][n] = __builtin_amdgcn_mfma_f32_16x16x32_bf16(Bt[n][k], At[m][k], acc[ai][bj][m][n], 0, 0, 0); __builtin_amdgcn_s_setprio(0); } while (0)
#define PG8_WAIT_V(n) asm volatile("s_waitcnt vmcnt(" #n ")" ::: "memory")
#define PG8_WAIT_L(n) asm volatile("s_waitcnt lgkmcnt(" #n ")" ::: "memory")
#define PG8_BAR __builtin_amdgcn_s_barrier()
#define PG8_SCHED __builtin_amdgcn_sched_barrier(0)
    Unit cur, nxt; int ui = 0;
    if (!S.next(0, cur)) return;
    f32x4 acc[2][2][4][2];
#pragma unroll
    for (int a = 0; a < 2; ++a)
#pragma unroll
        for (int b = 0; b < 2; ++b)
#pragma unroll
            for (int m = 0; m < 4; ++m)
#pragma unroll
                for (int n = 0; n < 2; ++n) acc[a][b][m][n] = (f32x4){0.f, 0.f, 0.f, 0.f};
    bf16x8 At[4][2], B0[2][2], B1[2][2];
    const char* cA = (const char*)g.A + (size_t)cur.pm * tstep; const char* cB = (const char*)g.Bt + (size_t)cur.pn * tstep;
    S.a_ready(cur);
    if constexpr (SP2) {
        PG8_STAGE(PG8_SB(0, 0), cB, voffB); PG8_STAGE(PG8_SB(0, 1), cB + hstep, voffB); PG8_STAGE(PG8_SA(0, 0), cA, voffA); PG8_STAGE(PG8_SA(0, 1), cA + hstep, voffA);
        if (wr == 1) PG8_BAR;
        PG8_WAIT_V(2); PG8_BAR;
        PG8_STAGE(PG8_SB(1, 0), cB + kstep, voffB); PG8_STAGE(PG8_SA(1, 0), cA + kstep, voffA); PG8_STAGE(PG8_SB(1, 1), cB + hstep + kstep, voffB);
        PG8_WAIT_V(6); PG8_BAR;
    } else {
        PG8_STAGE(PG8_SB(0, 0), cB, voffB); PG8_STAGE(PG8_SA(0, 0), cA, voffA); PG8_STAGE(PG8_SB(0, 1), cB + hstep, voffB); PG8_STAGE(PG8_SA(0, 1), cA + hstep, voffA);
        if (wr == 1) PG8_BAR;
        PG8_WAIT_V(4); PG8_BAR;
        PG8_STAGE(PG8_SB(1, 0), cB + kstep, voffB); PG8_STAGE(PG8_SA(1, 0), cA + kstep, voffA); PG8_STAGE(PG8_SB(1, 1), cB + hstep + kstep, voffB);
        PG8_WAIT_V(6); PG8_BAR;
    }
    for (;;) {
        const bool has_next = S.next(ui + 1, nxt);
        const char* nA = has_next ? (const char*)g.A + (size_t)nxt.pm * tstep : cA; const char* nB = has_next ? (const char*)g.Bt + (size_t)nxt.pn * tstep : cB;
        for (int t = 0; t < nt; t += 2) {
            const bool last = (t == nt - 2);
            const char* a1 = cA + (size_t)(t + 1) * kstep;
            const char* a2 = last ? nA : cA + (size_t)(t + 2) * kstep; const char* b2 = last ? nB : cB + (size_t)(t + 2) * kstep;
            const char* a3 = a2 + kstep; const char* b3 = b2 + kstep;
            if (last && has_next) S.a_ready(nxt);
            if constexpr (SP2) {
            PG8_LDB(B0, 0, 0); PG8_LDB(B1, 0, 1); PG8_SCHED; PG8_LDA(At, 0, 0); PG8_STAGE(PG8_SA(1, 1), a1 + hstep, voffA);
            PG8_WAIT_V(8); PG8_WAIT_L(0); PG8_BAR; PG8_MMA(0, 0, At, B0); PG8_MMA(0, 1, At, B1); PG8_BAR; PG8_SCHED;
            PG8_LDA(At, 0, 1); PG8_STAGE(PG8_SB(0, 0), b2, voffB); PG8_STAGE(PG8_SB(0, 1), b2 + hstep, voffB); PG8_STAGE(PG8_SA(0, 0), a2, voffA);
            PG8_WAIT_V(8); PG8_WAIT_L(0); PG8_BAR; PG8_MMA(1, 0, At, B0); PG8_MMA(1, 1, At, B1); PG8_BAR; PG8_SCHED;
            PG8_LDB(B0, 1, 0); PG8_LDB(B1, 1, 1); PG8_SCHED; PG8_LDA(At, 1, 0); PG8_STAGE(PG8_SA(0, 1), a2 + hstep, voffA);
            PG8_WAIT_V(8); PG8_WAIT_L(0); PG8_BAR; PG8_MMA(0, 0, At, B0); PG8_MMA(0, 1, At, B1); PG8_BAR; PG8_SCHED;
            PG8_LDA(At, 1, 1); PG8_STAGE(PG8_SB(1, 0), b3, voffB); PG8_STAGE(PG8_SB(1, 1), b3 + hstep, voffB); PG8_STAGE(PG8_SA(1, 0), a3, voffA);
            PG8_WAIT_V(8); PG8_WAIT_L(0); PG8_BAR; PG8_MMA(1, 0, At, B0); PG8_MMA(1, 1, At, B1); PG8_BAR; PG8_SCHED;
            } else {
            PG8_LDB(B0, 0, 0); PG8_SCHED; PG8_LDA(At, 0, 0); PG8_STAGE(PG8_SA(1, 1), a1 + hstep, voffA);
            PG8_WAIT_L(8); PG8_BAR; PG8_WAIT_L(0); PG8_MMA(0, 0, At, B0); PG8_BAR; PG8_SCHED;
            PG8_LDB(B1, 0, 1); PG8_STAGE(PG8_SB(0, 0), b2, voffB);
            PG8_BAR; PG8_WAIT_L(0); PG8_MMA(0, 1, At, B1); PG8_BAR;
            PG8_LDA(At, 0, 1); PG8_STAGE(PG8_SA(0, 0), a2, voffA);
            PG8_BAR; PG8_WAIT_L(0); PG8_MMA(1, 0, At, B0); PG8_BAR; PG8_SCHED;
            PG8_STAGE(PG8_SB(0, 1), b2 + hstep, voffB);
            PG8_WAIT_V(6); PG8_BAR; PG8_MMA(1, 1, At, B1); PG8_BAR;
            PG8_LDB(B0, 1, 0); PG8_SCHED; PG8_LDA(At, 1, 0); PG8_STAGE(PG8_SA(0, 1), a2 + hstep, voffA);
            PG8_WAIT_L(8); PG8_BAR; PG8_WAIT_L(0); PG8_MMA(0, 0, At, B0); PG8_BAR; PG8_SCHED;
            PG8_LDB(B1, 1, 1); PG8_STAGE(PG8_SB(1, 0), b3, voffB);
            PG8_BAR; PG8_WAIT_L(0); PG8_MMA(0, 1, At, B1); PG8_BAR;
            PG8_LDA(At, 1, 1); PG8_STAGE(PG8_SA(1, 0), a3, voffA);
            PG8_BAR; PG8_WAIT_L(0); PG8_MMA(1, 0, At, B0); PG8_BAR; PG8_SCHED;
            PG8_STAGE(PG8_SB(1, 1), b3 + hstep, voffB);
            PG8_WAIT_V(6); PG8_BAR; PG8_MMA(1, 1, At, B1); PG8_BAR;
            }
        }
        if constexpr (ALIGN_EPI) { if (wr == 0) PG8_BAR; }
        if constexpr (!Epi::AFTER_DRAIN) { E(acc, cur, wr, wc, fr, fq); S.done(cur); }
        if (!has_next) break;
#pragma unroll
        for (int a = 0; a < 2; ++a)
#pragma unroll
            for (int b = 0; b < 2; ++b)
#pragma unroll
                for (int m = 0; m < 4; ++m)
#pragma unroll
                    for (int n = 0; n < 2; ++n) acc[a][b][m][n] = (f32x4){0.f, 0.f, 0.f, 0.f};
        cur = nxt; cA = nA; cB = nB; ++ui;
        if constexpr (ALIGN_EPI) { if (wr == 1) PG8_BAR; }
    }
    PG8_WAIT_V(0);
    if constexpr (!ALIGN_EPI) { if (wr == 0) PG8_BAR; }
    PG8_BAR;
    if constexpr (Epi::AFTER_DRAIN) { E.fused(acc, cur, wr, wc, fr, fq, lds, wid, lane); S.done(cur); }
#undef PG8_SA
#undef PG8_SB
#undef PG8_STAGE
#undef PG8_LDA
#undef PG8_LDB
#undef PG8_MMA
#undef PG8_WAIT_V
#undef PG8_WAIT_L
#undef PG8_BAR
#undef PG8_SCHED
}
}
#define GAS __attribute__((address_space(1)))
#define LAS __attribute__((address_space(3)))
typedef unsigned short bf16;
typedef unsigned v4u __attribute__((ext_vector_type(4)));
typedef float f32x4 __attribute__((ext_vector_type(4)));
typedef short bf16x8 __attribute__((ext_vector_type(8)));
typedef GAS unsigned gu32;
typedef GAS unsigned long long gu64;
#define RLX_AGENT __ATOMIC_RELAXED, __HIP_MEMORY_SCOPE_AGENT
#define LDS_WAIT() asm volatile("s_waitcnt lgkmcnt(0)" ::: "memory")
#define VM_WAIT() asm volatile("s_waitcnt vmcnt(0)" ::: "memory")
__device__ __forceinline__ unsigned long long rt() { return __builtin_amdgcn_s_memrealtime(); }
__device__ __forceinline__ unsigned f2bf(float f) { unsigned u = __builtin_bit_cast(unsigned, f); return (u + 0x7fffu + ((u >> 16) & 1u)) >> 16; }
__device__ __forceinline__ unsigned pk2(float lo, float hi) { return f2bf(lo) | (f2bf(hi) << 16); }

#define XB_TMO      128
#define XB_XCNT(j)  (256  + 64 * (j))
#define XB_XSUB(j)  (1280 + 64 * (j))
#define XB_XGEN(j)  (2304 + 64 * (j))
#define XB_TOP      3328
#define XB_TOPGEN   3392
#define XCD_BAR_WORDS 3456
#define XB_SPIN_CAP (1u << 18)

__device__ __forceinline__ unsigned xb_ld(unsigned* p)              { return __hip_atomic_load(p, __ATOMIC_RELAXED, __HIP_MEMORY_SCOPE_AGENT); }
__device__ __forceinline__ unsigned xb_add(unsigned* p, unsigned v) { return __hip_atomic_fetch_add(p, v, __ATOMIC_RELAXED, __HIP_MEMORY_SCOPE_AGENT); }
__device__ __forceinline__ unsigned xb_xcc_id() { return (unsigned)__builtin_amdgcn_s_getreg((3 << 11) | 20) & 0xFu; }
#define XB_SPIN(cond, bar) do { unsigned _sp = 0; while (cond) { __builtin_amdgcn_s_sleep(1); \
    if ((++_sp & 255u) == 0u) { if (xb_ld(&(bar)[XB_TMO])) break; if (_sp > XB_SPIN_CAP) { atomicAdd(&(bar)[XB_TMO], 1u); break; } } } } while (0)

struct XcdBarrier {
    unsigned* bar; unsigned x;
    volatile LAS unsigned* st;
};

__device__ __forceinline__ XcdBarrier xcd_barrier_post(unsigned* bar, volatile LAS unsigned* st) {
    XcdBarrier b; b.bar = bar; b.x = xb_xcc_id(); b.st = st;
    if (threadIdx.x == 0) (void)xb_add(&bar[XB_XCNT(b.x)], 1u);
    return b;
}
__device__ __forceinline__ void xcd_barrier_complete(unsigned* bar, unsigned x, unsigned& nloc, unsigned& nx) {
    const unsigned G = gridDim.x * gridDim.y * gridDim.z;
    unsigned sum, cnt, mine, sp = 0u;
    for (;;) {
        sum = 0u; cnt = 0u; mine = 0u;
#pragma unroll
        for (unsigned j = 0; j < 16; ++j) { const unsigned c = xb_ld(&bar[XB_XCNT(j)]); sum += c; cnt += (c > 0u) ? 1u : 0u; mine = (j == x) ? c : mine; }
        if (sum == G) break;
        __builtin_amdgcn_s_sleep(1);
        if ((++sp & 255u) == 0u) { if (xb_ld(&bar[XB_TMO])) break; if (sp > XB_SPIN_CAP) { atomicAdd(&bar[XB_TMO], 1u); break; } }
    }
    nloc = mine > 0u ? mine : 1u; nx = cnt > 0u ? cnt : 1u;
}

__device__ __forceinline__ void xcd_barrier(const XcdBarrier& b) {
    asm volatile("s_waitcnt vmcnt(0)" ::: "memory");
    __syncthreads();
    if (threadIdx.x == 0) {
        unsigned* bar = b.bar;
        __builtin_amdgcn_s_waitcnt(0);
        unsigned nloc = b.st[0], nx = b.st[1];
        if (nloc == 0u) { xcd_barrier_complete(bar, b.x, nloc, nx); b.st[0] = nloc; b.st[1] = nx; }
        const unsigned old = xb_add(&bar[XB_XSUB(b.x)], 1u);
        const unsigned gen = old / nloc;
        if (old + 1u == (gen + 1u) * nloc) {
            __builtin_amdgcn_fence(__ATOMIC_RELEASE, "agent");
            asm volatile("s_waitcnt vmcnt(0)" ::: "memory");
            const unsigned og = xb_add(&bar[XB_TOP], 1u);
            const unsigned tg = og / nx;
            if (og + 1u == (tg + 1u) * nx) xb_add(&bar[XB_TOPGEN], 1u);
            else XB_SPIN(xb_ld(&bar[XB_TOPGEN]) == tg, bar);
            __builtin_amdgcn_fence(__ATOMIC_ACQUIRE, "agent");
            xb_add(&bar[XB_XGEN(b.x)], 1u);
            asm volatile("s_waitcnt vmcnt(0)" ::: "memory");
        } else {
            XB_SPIN(xb_ld(&bar[XB_XGEN(b.x)]) == gen, bar);
            __builtin_amdgcn_fence(__ATOMIC_ACQUIRE, "agent");
            asm volatile("s_waitcnt vmcnt(0)" ::: "memory");
        }
    }
    __syncthreads();
}
constexpr int T = 24576, D = 2048, DEPTH = 4, NIN = 7184, NINP = 7424, PROJW = 7168, DFF = 5632, NUP = 11264;
constexpr int NCHUNK = 192;
constexpr float EPS = 1e-6f;
constexpr size_t MiB = 1u << 20;
constexpr size_t WS_CTL = 0, CTL_ZERO_BYTES = 3 * MiB;
constexpr size_t WS_SUMSQ = 1 * MiB;
constexpr size_t WS_W = 3 * MiB;
constexpr size_t WO_IN = 0, WO_OUT = (size_t)NINP * D * 2, WO_UP = WO_OUT + (size_t)D * D * 2, WO_DOWN = WO_UP + (size_t)NUP * D * 2;
constexpr size_t WS_X = 106 * MiB;
constexpr size_t WS_XB = 298 * MiB;
constexpr size_t WS_PROJ = 394 * MiB;
constexpr size_t WS_S = 730 * MiB;
constexpr size_t WS_U = 394 * MiB;
constexpr size_t WS_MIX = 922 * MiB;
constexpr size_t WS_ACT = 922 * MiB;
constexpr size_t WS_SM = 1186 * MiB;
constexpr size_t WS_GATES = WS_SM, WS_BQ = WS_SM + 2 * MiB, WS_BK = WS_SM + 3 * MiB, WS_KMAX = WS_SM + 4 * MiB, WS_BLAST = WS_KMAX + 8192, WS_US = WS_KMAX + 16384, WS_DN = WS_SM + 5 * MiB;
constexpr size_t WS_END = 1194 * MiB;
static_assert(WO_DOWN + (size_t)D * DFF * 2 <= 103 * MiB && WS_W + 103 * MiB <= WS_X && WS_SUMSQ + (size_t)9 * T * 8 <= CTL_ZERO_BYTES && WS_X + (size_t)T * D * 4 <= WS_XB && WS_XB + (size_t)T * D * 2 <= WS_PROJ, "ws map 1");
static_assert(WS_PROJ + (size_t)T * PROJW * 2 <= WS_S && WS_S + (size_t)1536 * 65536 * 2 <= WS_MIX && WS_U + (size_t)T * NUP * 2 <= WS_MIX && WS_ACT + (size_t)T * DFF * 2 <= WS_SM, "ws map 2");
constexpr int CW_BAR = 4096;
constexpr int LDS_BYTES = 147456, MISC_OFF = 147456 - 256;
constexpr int TPITCH = 528;
constexpr int VT_OFF = 0, KT_OFF = 128 * TPITCH, SC_OFF = 2 * 128 * TPITCH;
static_assert(SC_OFF + 4096 <= MISC_OFF, "lds map");

typedef short bf16x8 __attribute__((ext_vector_type(8)));
typedef short s16x4 __attribute__((ext_vector_type(4)));
typedef unsigned u32x2 __attribute__((ext_vector_type(2)));
__device__ __forceinline__ float bf2f(unsigned short b) { return __uint_as_float(((unsigned)b) << 16); }
__device__ __forceinline__ unsigned pkbf(float lo, float hi) { return pg8::cvt_pk_bf16(lo, hi); }
__device__ __forceinline__ float wave_sum(float v) {
#pragma unroll
    for (int o = 1; o < 64; o <<= 1) v += __shfl_xor(v, o);
    return v;
}
__device__ __forceinline__ s16x4 tr16(LAS const unsigned char* p) { typedef short v4i16_t __attribute__((ext_vector_type(4))); return __builtin_bit_cast(s16x4, __builtin_amdgcn_ds_read_tr16_b64_v4i16((LAS v4i16_t*)p)); }
__device__ __forceinline__ bf16x8 cat8(s16x4 a, s16x4 b) { bf16x8 r; r[0] = a[0]; r[1] = a[1]; r[2] = a[2]; r[3] = a[3]; r[4] = b[0]; r[5] = b[1]; r[6] = b[2]; r[7] = b[3]; return r; }
typedef __amdgpu_buffer_rsrc_t rsrc_t;
__device__ __forceinline__ rsrc_t mkrsrc(const void* base, unsigned nbytes) {
    const unsigned long long b = (unsigned long long)base; const unsigned lo = __builtin_amdgcn_readfirstlane((unsigned)b), hi = __builtin_amdgcn_readfirstlane((unsigned)(b >> 32));
    return __builtin_amdgcn_make_buffer_rsrc((void*)(((unsigned long long)hi << 32) | lo), 0, nbytes, 0x00020000); }
__device__ __forceinline__ v4u bld128(rsrc_t rs, unsigned voff, unsigned soff) { return __builtin_amdgcn_raw_buffer_load_b128(rs, voff, soff, 0); }
__device__ __forceinline__ u32x2 bld64(rsrc_t rs, unsigned voff, unsigned soff) { return __builtin_amdgcn_raw_buffer_load_b64(rs, voff, soff, 0); }
__device__ __forceinline__ void bst64(u32x2 v, rsrc_t rs, unsigned voff, unsigned soff) { __builtin_amdgcn_raw_buffer_store_b64(v, rs, voff, soff, 0); }
__device__ __forceinline__ int unit_of(int dir, int cg, int h) { return (dir * NCHUNK + cg) * 4 + h; }

struct Ctx {
    LAS unsigned char* lds; int tid, lane, wave, G, bid;
    const float *x_prompt, *x_sample, *norm_mix_g, *w_in, *gate_b, *conv_w, *conv_norm_g, *mlstm_norm_g, *w_out, *norm_ffn_g, *w_up, *ffn_conv_w, *ffn_conv_b, *w_down, *final_norm_g;
    float* out; unsigned char* ws;
};

__device__ __forceinline__ void phase_x0(const Ctx& C) {
    int tid_ = C.tid; asm volatile("" : "+v"(tid_)); const int lane_ = tid_ & 63; (void)lane_;
    const int gw = C.bid * 8 + C.wave, NGW = C.G * 8;
    float* x = (float*)(C.ws + WS_X); bf16* xb = (bf16*)(C.ws + WS_XB); unsigned long long* ss0 = (unsigned long long*)(C.ws + WS_SUMSQ);
    for (int r = gw; r < T; r += NGW) {
        const float* src = r < 16384 ? C.x_prompt + (size_t)r * D : C.x_sample + (size_t)(r - 16384) * D;
        const f32x4* s4 = (const f32x4*)src + lane_; f32x4 v[8]; float ss = 0.f;
#pragma unroll
        for (int j = 0; j < 8; ++j) { v[j] = s4[64 * j]; ss += (v[j][0] * v[j][0] + v[j][1] * v[j][1]) + (v[j][2] * v[j][2] + v[j][3] * v[j][3]); }
        ss = wave_sum(ss);
        f32x4* d4 = (f32x4*)(x + (size_t)r * D) + lane_; u32x2* b2 = (u32x2*)(xb + (size_t)r * D) + lane_;
#pragma unroll
        for (int j = 0; j < 8; ++j) { d4[64 * j] = v[j]; u32x2 w; w.x = pkbf(v[j][0], v[j][1]); w.y = pkbf(v[j][2], v[j][3]); b2[64 * j] = w; }
        if (lane_ == 0) ss0[r] = pg8::ss_fix(ss);
    }
}

__device__ __forceinline__ void tr_item(const float* W, int K, int Npad, int Nsrc, bf16* WT, const float* gain, int qlo, int qhi, LAS float* scr, int item, int lane) {
    const int nblk = Npad / 32, kb = item / nblk, nb = item % nblk, k0 = 64 * kb, n0 = 32 * nb;
    const int n = n0 + (lane & 31); const float cs = (n >= qlo && n < qhi) ? 0.0625f : 1.0f;
#pragma unroll 8
    for (int i = 0; i < 32; ++i) { const int kk = 2 * i + (lane >> 5); float w = (n < Nsrc) ? W[(size_t)(k0 + kk) * Nsrc + n] : 0.f; if (gain) w *= gain[k0 + kk]; scr[kk * 33 + (lane & 31)] = w * cs; }
    asm volatile("s_waitcnt lgkmcnt(0)" ::: "memory");
    const int c = lane & 7;
#pragma unroll
    for (int j = 0; j < 4; ++j) { const int nn = (lane >> 3) + 8 * j; const LAS float* s = scr + (8 * c) * 33 + nn;
        v4u o; o.x = pkbf(s[0 * 33], s[1 * 33]); o.y = pkbf(s[2 * 33], s[3 * 33]); o.z = pkbf(s[4 * 33], s[5 * 33]); o.w = pkbf(s[6 * 33], s[7 * 33]);
        *(v4u*)(WT + (size_t)(n0 + nn) * K + k0 + 8 * c) = o; }
    asm volatile("s_waitcnt lgkmcnt(0)" ::: "memory");
}
__device__ __forceinline__ void phase_w(const Ctx& C, int l) {
    int tid_ = C.tid; asm volatile("" : "+v"(tid_)); const int lane_ = tid_ & 63; (void)lane_;
    LAS float* scr = (LAS float*)(C.lds + C.wave * 16384);
    const int gw = C.bid * 8 + C.wave, NGW = C.G * 8;
    constexpr int I_IN = (D / 64) * (NINP / 32), I_OUT = (D / 64) * (D / 32), I_UP = (D / 64) * (NUP / 32), I_DOWN = (DFF / 64) * (D / 32);
    constexpr int NITEMS = I_IN + I_OUT + I_UP + I_DOWN;
    bf16* wb = (bf16*)(C.ws + WS_W);
    for (int it = gw; it < NITEMS; it += NGW) {
        int r = it;
        if (r < I_IN) { tr_item(C.w_in + (size_t)l * D * NIN, D, NINP, NIN, (bf16*)((unsigned char*)wb + WO_IN), C.norm_mix_g + l * D, 3072, 4096, scr, r, lane_); continue; } r -= I_IN;
        if (r < I_OUT) { tr_item(C.w_out + (size_t)l * D * D, D, D, D, (bf16*)((unsigned char*)wb + WO_OUT), nullptr, 0, 0, scr, r, lane_); continue; } r -= I_OUT;
        if (r < I_UP) { tr_item(C.w_up + (size_t)l * D * NUP, D, NUP, NUP, (bf16*)((unsigned char*)wb + WO_UP), C.norm_ffn_g + l * D, 0, 0, scr, r, lane_); continue; } r -= I_UP;
        tr_item(C.w_down + (size_t)l * DFF * D, DFF, D, D, (bf16*)((unsigned char*)wb + WO_DOWN), nullptr, 0, 0, scr, r, lane_);
    }
}

__device__ __forceinline__ void unpack8(const v4u& w, float (&f)[8]) {
    f[0] = __uint_as_float(w.x << 16); f[1] = __uint_as_float(w.x & 0xffff0000u); f[2] = __uint_as_float(w.y << 16); f[3] = __uint_as_float(w.y & 0xffff0000u);
    f[4] = __uint_as_float(w.z << 16); f[5] = __uint_as_float(w.z & 0xffff0000u); f[6] = __uint_as_float(w.w << 16); f[7] = __uint_as_float(w.w & 0xffff0000u);
}
__device__ __forceinline__ void phase_conv(const Ctx& C, int l) {
    int tid_ = C.tid; asm volatile("" : "+v"(tid_)); const int lane_ = tid_ & 63; (void)lane_;
    const int gw = C.bid * 8 + C.wave, NGW = C.G * 8;
    const bf16* proj = (const bf16*)(C.ws + WS_PROJ); bf16* mix = (bf16*)(C.ws + WS_MIX);
    const float* cw = C.conv_w + (size_t)l * 3 * 1024; const float* cg = C.conv_norm_g + (size_t)l * 1024;
    const int c0 = 16 * lane_;
    for (int t = gw; t < T; t += NGW) {
        const int tlo = t < 16384 ? 0 : 16384 + ((t - 16384) & ~2047), thi = t < 16384 ? 16384 : tlo + 2048;
        float y[16];
#pragma unroll
        for (int i = 0; i < 16; ++i) y[i] = 0.f;
#pragma unroll
        for (int k = 0; k < 3; ++k) { const int tt = t + k - 1;
            if (tt >= tlo && tt < thi) { const bf16* rp = proj + (size_t)tt * PROJW + c0;
#pragma unroll
                for (int hh = 0; hh < 2; ++hh) { const v4u a = *(const v4u*)(rp + 1024 + 8 * hh), b = *(const v4u*)(rp + 2048 + 8 * hh); float fa[8], fb[8]; unpack8(a, fa); unpack8(b, fb);
#pragma unroll
                    for (int i = 0; i < 8; ++i) y[8 * hh + i] += cw[k * 1024 + c0 + 8 * hh + i] * (fa[i] * fb[i]); } } }
        float ss = 0.f;
        { const bf16* rp = proj + (size_t)t * PROJW + c0;
#pragma unroll
          for (int hh = 0; hh < 2; ++hh) { const v4u a = *(const v4u*)(rp + 8 * hh); float fa[8]; unpack8(a, fa);
#pragma unroll
              for (int i = 0; i < 8; ++i) { y[8 * hh + i] *= fa[i]; ss += y[8 * hh + i] * y[8 * hh + i]; } } }
        ss += __shfl_xor(ss, 1); ss += __shfl_xor(ss, 2); ss += __shfl_xor(ss, 4);
        const float rn = rsqrtf(ss * (1.0f / 128.0f) + EPS);
#pragma unroll
        for (int hh = 0; hh < 2; ++hh) { v4u o; float z[8];
#pragma unroll
            for (int i = 0; i < 8; ++i) z[i] = y[8 * hh + i] * rn * cg[c0 + 8 * hh + i];
            o.x = pkbf(z[0], z[1]); o.y = pkbf(z[2], z[3]); o.z = pkbf(z[4], z[5]); o.w = pkbf(z[6], z[7]);
            *(v4u*)(mix + (size_t)t * D + c0 + 8 * hh) = o; }
    }
}

__device__ __forceinline__ void stage_tile(int tid, rsrc_t rsP, unsigned colbytes, LAS unsigned char* dst, const LAS float* rowscale) {
    const int row0 = tid >> 5, c16 = tid & 31;
    const unsigned vo = (unsigned)(row0 * (PROJW * 2) + c16 * 16);
    LAS unsigned char* d0 = dst + row0 * TPITCH + c16 * 16;
#pragma unroll
    for (int i = 0; i < 8; ++i) {
        v4u v = bld128(rsP, vo, colbytes + (unsigned)(i * 16 * PROJW * 2));
        if (rowscale) { float f[8]; unpack8(v, f); const float s = rowscale[row0 + 16 * i];
            v.x = pkbf(f[0] * s, f[1] * s); v.y = pkbf(f[2] * s, f[3] * s); v.z = pkbf(f[4] * s, f[5] * s); v.w = pkbf(f[6] * s, f[7] * s); }
        *(LAS v4u*)(d0 + i * 16 * TPITCH) = v;
        if (i == 3) __builtin_amdgcn_sched_barrier(0); }
}

__device__ __forceinline__ void phase_m1(const Ctx& C) {
    const bf16* proj = (const bf16*)(C.ws + WS_PROJ); const float* gates = (const float*)(C.ws + WS_GATES);
    float* BQ = (float*)(C.ws + WS_BQ); float* BK = (float*)(C.ws + WS_BK); float* KMAX = (float*)(C.ws + WS_KMAX); float* BLAST = (float*)(C.ws + WS_BLAST); float* DN = (float*)(C.ws + WS_DN);
    bf16* S = (bf16*)(C.ws + WS_S);
    LAS unsigned char* VT = C.lds + VT_OFF; LAS unsigned char* KT = C.lds + KT_OFF; LAS float* SC = (LAS float*)(C.lds + SC_OFF);
    const int wave = C.wave;
    for (int un = C.bid; un < NCHUNK * 4; un += C.G) {
        int tid = C.tid; asm volatile("" : "+v"(tid));
        const int lane = tid & 63, fr = lane & 15, fq = lane >> 4, q4 = fr >> 2, p4 = fr & 3;
        const int cg = un >> 2, h = un & 3, t0 = cg * 128;
        const int dir = (tid >> 7) & 1, j = tid & 127;
        float ip = 0.f;
        __syncthreads();
        if (tid < 256) { const float* gp = gates + (size_t)(t0 + j) * 16; ip = gp[8 * dir + h]; const float fp = gp[8 * dir + 4 + h];
            SC[tid] = fminf(fp, 0.f) - log1pf(__expf(-fabsf(fp))); }
        const rsrc_t rsP = mkrsrc(proj + (size_t)t0 * PROJW, 128u * PROJW * 2u);
        stage_tile(tid, rsP, (unsigned)((5120 + 256 * h) * 2), VT, nullptr);
        __syncthreads();
        float bqv = 0.f, bkv = -3.0e38f;
        if (tid < 256) { float s = 0.f; if (dir == 0) { for (int i = 0; i <= j; ++i) s += SC[i]; } else { for (int i = j; i < 128; ++i) s += SC[128 + i]; } bqv = s; bkv = ip - s; }
        float mx = bkv;
#pragma unroll
        for (int o = 1; o < 64; o <<= 1) mx = fmaxf(mx, __shfl_xor(mx, o));
        if (lane == 0 && wave < 4) SC[768 + wave] = mx;
        __syncthreads();
        if (tid < 256) { const float kmax = fmaxf(SC[768 + 2 * dir], SC[768 + 2 * dir + 1]); SC[512 + tid] = __expf(bkv - kmax);
            BQ[(size_t)(dir * 4 + h) * T + t0 + j] = bqv; BK[(size_t)(dir * 4 + h) * T + t0 + j] = bkv;
            const int u = unit_of(dir, cg, h);
            if (j == 0) KMAX[u] = kmax;
            if ((dir == 0 && j == 127) || (dir == 1 && j == 0)) BLAST[u] = bqv; }
        for (int dd = 0; dd < 2; ++dd) {
            __syncthreads();
            stage_tile(tid, rsP, (unsigned)((4096 + 256 * h) * 2), KT, SC + 512 + dd * 128);
            __syncthreads();
            const int u = unit_of(dd, cg, h);
            if (tid < 256) { float s = 0.f; for (int r = 0; r < 128; ++r) s += bf2f(*(const LAS unsigned short*)(KT + r * TPITCH + 2 * tid)); DN[(size_t)u * 256 + tid] = s; }
            f32x4 acc[2][16];
#pragma unroll
            for (int a = 0; a < 2; ++a)
#pragma unroll
                for (int b = 0; b < 16; ++b) acc[a][b] = (f32x4){0.f, 0.f, 0.f, 0.f};
#pragma unroll 1
            for (int ks = 0; ks < 4; ++ks) {
                const int rb = (32 * ks + 8 * fq + q4) * TPITCH + 8 * p4;
                bf16x8 vf[2];
#pragma unroll
                for (int a = 0; a < 2; ++a) { const int eo = (32 * wave + 16 * a) * 2; vf[a] = cat8(tr16(VT + rb + eo), tr16(VT + rb + 4 * TPITCH + eo)); }
#pragma unroll
                for (int b = 0; b < 16; ++b) { const bf16x8 kf = cat8(tr16(KT + rb + 32 * b), tr16(KT + rb + 4 * TPITCH + 32 * b));
#pragma unroll
                    for (int a = 0; a < 2; ++a) acc[a][b] = __builtin_amdgcn_mfma_f32_16x16x32_bf16(kf, vf[a], acc[a][b], 0, 0, 0); }
            }
            const rsrc_t rsS = mkrsrc(S + (size_t)u * 65536, 131072u);
            const unsigned sv = (unsigned)(fr * 512 + 8 * fq);
#pragma unroll
            for (int a = 0; a < 2; ++a)
#pragma unroll
                for (int b = 0; b < 16; ++b) { u32x2 w; w.x = pkbf(acc[a][b][0], acc[a][b][1]); w.y = pkbf(acc[a][b][2], acc[a][b][3]);
                    bst64(w, rsS, sv + 32u * b, (unsigned)((32 * wave + 16 * a) * 512)); }
        }
    }
}

__device__ __forceinline__ void phase_m2(const Ctx& C) {
    const float* KMAX = (const float*)(C.ws + WS_KMAX); const float* BLAST = (const float*)(C.ws + WS_BLAST); float* DN = (float*)(C.ws + WS_DN); float* US = (float*)(C.ws + WS_US);
    bf16* S = (bf16*)(C.ws + WS_S);
    LAS float* SC = (LAS float*)(C.lds + SC_OFF);
    int tid = C.tid; asm volatile("" : "+v"(tid));
    constexpr int N_PM = 256, N_SM = 1024, N_V = 40;
    for (int it = C.bid; it < N_PM + N_SM + N_V; it += C.G) {
        int dir, seq, h, slab;
        if (it < N_PM) { dir = it >> 7; h = (it >> 5) & 3; slab = it & 31; seq = 0; }
        else if (it < N_PM + N_SM) { const int r = it - N_PM; dir = r >> 9; seq = 1 + ((r >> 7) & 3); h = (r >> 5) & 3; slab = r & 31; }
        else { const int r = it - N_PM - N_SM; dir = r / 20; const int sh = r % 20; seq = sh >> 2; h = sh & 3; slab = 32; }
        const int c0 = seq == 0 ? 0 : 128 + 16 * (seq - 1), nc = seq == 0 ? 128 : 16;
        __syncthreads();
        if (tid < nc) { const int cg = dir == 0 ? c0 + tid : c0 + nc - 1 - tid; const int u = unit_of(dir, cg, h); SC[tid] = KMAX[u]; SC[128 + tid] = BLAST[u]; }
        __syncthreads();
        if (tid == 0) { float m = 0.f; for (int c = 0; c < nc; ++c) { SC[256 + c] = m; m = SC[128 + c] + fmaxf(m, SC[c]); } }
        __syncthreads();
        if (tid < nc) { const float m = SC[256 + tid], k = SC[tid], M = fmaxf(m, k); SC[384 + tid] = __expf(m - M); SC[512 + tid] = __expf(k - M);
            if (slab == 32) { const int cg = dir == 0 ? c0 + tid : c0 + nc - 1 - tid; float* us = US + (size_t)unit_of(dir, cg, h) * 4; us[0] = __expf(m - M); us[1] = __expf(k - M); us[2] = M; us[3] = 0.f; } }
        __syncthreads();
        if (slab < 32) {
            float c4[4] = {0.f, 0.f, 0.f, 0.f};
            const size_t eoff = (size_t)slab * 2048 + tid * 4;
            for (int cb = 0; cb < nc; cb += 4) {
                u32x2 d[4]; bf16* ptr[4];
#pragma unroll
                for (int i = 0; i < 4; ++i) { const int c = cb + i; const int cg = dir == 0 ? c0 + c : c0 + nc - 1 - c; ptr[i] = S + (size_t)unit_of(dir, cg, h) * 65536 + eoff; d[i] = *(const u32x2*)ptr[i]; }
#pragma unroll
                for (int i = 0; i < 4; ++i) { const float a = SC[384 + cb + i], b = SC[512 + cb + i];
                    u32x2 w; w.x = pkbf(c4[0], c4[1]); w.y = pkbf(c4[2], c4[3]); *(u32x2*)ptr[i] = w;
                    c4[0] = a * c4[0] + b * __uint_as_float(d[i].x << 16); c4[1] = a * c4[1] + b * __uint_as_float(d[i].x & 0xffff0000u);
                    c4[2] = a * c4[2] + b * __uint_as_float(d[i].y << 16); c4[3] = a * c4[3] + b * __uint_as_float(d[i].y & 0xffff0000u); }
            }
        } else if (tid < 256) {
            float nv = 0.f;
            for (int c = 0; c < nc; ++c) { const int cg = dir == 0 ? c0 + c : c0 + nc - 1 - c; float* p = DN + (size_t)unit_of(dir, cg, h) * 256 + tid; const float dv = *p; *p = nv; nv = SC[384 + c] * nv + SC[512 + c] * dv; }
        }
    }
}

__device__ __forceinline__ void phase_m3(const Ctx& C, int l) {
    const bf16* proj = (const bf16*)(C.ws + WS_PROJ); bf16* mix = (bf16*)(C.ws + WS_MIX);
    const float* BQ = (const float*)(C.ws + WS_BQ); const float* BK = (const float*)(C.ws + WS_BK); const float* KMAX = (const float*)(C.ws + WS_KMAX);
    const float* DN = (const float*)(C.ws + WS_DN); const float* US = (const float*)(C.ws + WS_US); const bf16* S = (const bf16*)(C.ws + WS_S);
    const float* mg = C.mlstm_norm_g + (size_t)l * 1024;
    LAS unsigned char* VT = C.lds + VT_OFF; LAS unsigned char* KT = C.lds + KT_OFF; LAS float* SC = (LAS float*)(C.lds + SC_OFF);
    const int wave = C.wave;
    for (int un = C.bid; un < NCHUNK * 4; un += C.G) {
        int tid = C.tid; asm volatile("" : "+v"(tid));
        const int lane = tid & 63, fr = lane & 15, fq = lane >> 4, q4 = fr >> 2, p4 = fr & 3;
        const int cg = un >> 2, h = un & 3, t0 = cg * 128, tl = 16 * wave + fr, t = t0 + tl;
        const rsrc_t rsP = mkrsrc(proj + (size_t)t0 * PROJW, 128u * PROJW * 2u);
        const unsigned pv = (unsigned)(tl * (PROJW * 2));
        bf16x8 qf[8];
#pragma unroll
        for (int ks = 0; ks < 8; ++ks) qf[ks] = __builtin_bit_cast(bf16x8, bld128(rsP, pv + 16u * fq + 64u * ks, (unsigned)((3072 + 256 * h) * 2)));
        __syncthreads();
        stage_tile(tid, rsP, (unsigned)((5120 + 256 * h) * 2), VT, nullptr);
        bf16x8 pf[2][4]; float al[2], inv[2];
#pragma unroll
        for (int dir = 0; dir < 2; ++dir) {
            const int u = unit_of(dir, cg, h);
            { int tx = tid; asm volatile("" : "+v"(tx));
              if (tx < 128) SC[256 + tx] = __expf(BK[(size_t)(dir * 4 + h) * T + t0 + tx] - KMAX[u]);
              if (tx >= 256) SC[tx - 256] = DN[(size_t)u * 256 + tx - 256]; }
            __syncthreads();
            stage_tile(tid, rsP, (unsigned)((4096 + 256 * h) * 2), KT, SC + 256);
            __syncthreads();
            const float be = US[(size_t)u * 4 + 1], MM = US[(size_t)u * 4 + 2], bqt = BQ[(size_t)(dir * 4 + h) * T + t];
            al[dir] = US[(size_t)u * 4];
            float qn = 0.f;
#pragma unroll
            for (int ks = 0; ks < 8; ++ks) {
                const f32x4 n0 = *(const LAS f32x4*)(SC + 32 * ks + 8 * fq), n1 = *(const LAS f32x4*)(SC + 32 * ks + 8 * fq + 4);
#pragma unroll
                for (int j = 0; j < 4; ++j) qn += bf2f((unsigned short)qf[ks][j]) * n0[j] + bf2f((unsigned short)qf[ks][4 + j]) * n1[j];
                __builtin_amdgcn_sched_barrier(0);
            }
            qn += __shfl_xor(qn, 16); qn += __shfl_xor(qn, 32);
            float rsum = 0.f;
            const int sp_lo = dir == 0 ? 0 : (wave >> 1), sp_hi = dir == 0 ? (wave >> 1) : 3;
#pragma unroll
            for (int sp = 0; sp < 4; ++sp) {
                v4u pw; pw.x = 0u; pw.y = 0u; pw.z = 0u; pw.w = 0u;
                if (sp >= sp_lo && sp <= sp_hi) {
                    f32x4 st0 = (f32x4){0.f, 0.f, 0.f, 0.f}, st1 = (f32x4){0.f, 0.f, 0.f, 0.f};
                    LAS const unsigned char* kb = KT + (32 * sp + fr) * TPITCH + 16 * fq;
#pragma unroll
                    for (int ks = 0; ks < 8; ++ks) { const bf16x8 k0 = *(LAS const bf16x8*)(kb + 64 * ks), k1 = *(LAS const bf16x8*)(kb + 16 * TPITCH + 64 * ks);
                        st0 = __builtin_amdgcn_mfma_f32_16x16x32_bf16(k0, qf[ks], st0, 0, 0, 0); st1 = __builtin_amdgcn_mfma_f32_16x16x32_bf16(k1, qf[ks], st1, 0, 0, 0);
                        if ((ks & 3) == 3) __builtin_amdgcn_sched_barrier(0); }
                    int tlx = tl - 4 * fq; asm volatile("" : "+v"(tlx));
#pragma unroll
                    for (int jj = 0; jj < 4; ++jj) { const int s0 = 32 * sp + jj, s1 = s0 + 16;
                        const bool k0 = dir == 0 ? (s0 <= tlx) : (s0 >= tlx), k1 = dir == 0 ? (s1 <= tlx) : (s1 >= tlx);
                        st0[jj] = k0 ? st0[jj] * be : 0.f; st1[jj] = k1 ? st1[jj] * be : 0.f; rsum += st0[jj] + st1[jj]; }
                    pw.x = pkbf(st0[0], st0[1]); pw.y = pkbf(st0[2], st0[3]); pw.z = pkbf(st1[0], st1[1]); pw.w = pkbf(st1[2], st1[3]);
                }
                pf[dir][sp] = __builtin_bit_cast(bf16x8, pw);
            }
            rsum += __shfl_xor(rsum, 16); rsum += __shfl_xor(rsum, 32);
            const float den = al[dir] * qn + rsum, lower = __expf(-bqt - MM);
            inv[dir] = __builtin_amdgcn_rcpf(fmaxf(fabsf(den), lower));
            __syncthreads();
        }
        f32x4 hs[16];
        const unsigned cv = (unsigned)(fr * 512 + 16 * fq);
#pragma unroll
        for (int qt = 0; qt < 4; ++qt) {
#pragma unroll
            for (int dir = 0; dir < 2; ++dir) {
                const rsrc_t rsS = mkrsrc(S + (size_t)unit_of(dir, cg, h) * 65536, 131072u);
                const int sp_lo = dir == 0 ? 0 : (wave >> 1), sp_hi = dir == 0 ? (wave >> 1) : 3;
                f32x4 acc[4];
#pragma unroll
                for (int e4 = 0; e4 < 4; ++e4) acc[e4] = (f32x4){0.f, 0.f, 0.f, 0.f};
#pragma unroll
                for (int ks = 0; ks < 8; ++ks) {
#pragma unroll
                    for (int e4 = 0; e4 < 4; ++e4) { const bf16x8 cf = __builtin_bit_cast(bf16x8, bld128(rsS, cv + 64u * ks, (unsigned)((4 * qt + e4) * 8192))); acc[e4] = __builtin_amdgcn_mfma_f32_16x16x32_bf16(cf, qf[ks], acc[e4], 0, 0, 0); }
                    if (ks & 1) __builtin_amdgcn_sched_barrier(0);
                }
#pragma unroll
                for (int e4 = 0; e4 < 4; ++e4) acc[e4] = acc[e4] * al[dir];
#pragma unroll
                for (int sp = 0; sp < 4; ++sp) {
                    if (sp >= sp_lo && sp <= sp_hi) {
                        LAS const unsigned char* vb = VT + (32 * sp + 4 * fq + q4) * TPITCH + 8 * p4 + 32 * 4 * qt;
#pragma unroll
                        for (int e4 = 0; e4 < 4; ++e4) { const bf16x8 vf = cat8(tr16(vb + 32 * e4), tr16(vb + 16 * TPITCH + 32 * e4)); acc[e4] = __builtin_amdgcn_mfma_f32_16x16x32_bf16(vf, pf[dir][sp], acc[e4], 0, 0, 0); }
                    }
                }
#pragma unroll
                for (int e4 = 0; e4 < 4; ++e4) { if (dir == 0) hs[4 * qt + e4] = acc[e4] * inv[0]; else hs[4 * qt + e4] += acc[e4] * inv[1]; }
                __builtin_amdgcn_sched_barrier(0);
            }
        }
        float ss = 0.f;
#pragma unroll
        for (int eb = 0; eb < 16; ++eb) ss += (hs[eb][0] * hs[eb][0] + hs[eb][1] * hs[eb][1]) + (hs[eb][2] * hs[eb][2] + hs[eb][3] * hs[eb][3]);
        ss += __shfl_xor(ss, 16); ss += __shfl_xor(ss, 32);
        const float rn = rsqrtf(ss * (1.0f / 256.0f) + EPS);
        const rsrc_t rsG = mkrsrc(mg + 256 * h, 1024u); const rsrc_t rsM = mkrsrc(mix + (size_t)t0 * D, 128u * D * 2u);
#pragma unroll
        for (int eb = 0; eb < 16; ++eb) { const f32x4 g4 = __builtin_bit_cast(f32x4, bld128(rsG, 16u * fq + 64u * eb, 0u));
            const u32x2 ow = bld64(rsP, pv + 8u * fq + 32u * eb, (unsigned)((6144 + 256 * h) * 2));
            const float o0 = __uint_as_float(ow.x << 16), o1 = __uint_as_float(ow.x & 0xffff0000u), o2 = __uint_as_float(ow.y << 16), o3 = __uint_as_float(ow.y & 0xffff0000u);
            const float y0 = hs[eb][0] * rn * g4[0] * __builtin_amdgcn_rcpf(1.0f + __expf(-o0)), y1 = hs[eb][1] * rn * g4[1] * __builtin_amdgcn_rcpf(1.0f + __expf(-o1));
            const float y2 = hs[eb][2] * rn * g4[2] * __builtin_amdgcn_rcpf(1.0f + __expf(-o2)), y3 = hs[eb][3] * rn * g4[3] * __builtin_amdgcn_rcpf(1.0f + __expf(-o3));
            if ((eb & 3) == 3) __builtin_amdgcn_sched_barrier(0);
            u32x2 w; w.x = pkbf(y0, y1); w.y = pkbf(y2, y3); bst64(w, rsM, (unsigned)(tl * (D * 2)) + 8u * fq + 32u * eb, (unsigned)((1024 + 256 * h) * 2)); }
    }
}

__device__ __forceinline__ void phase_glu(const Ctx& C, int l) {
    int tid_ = C.tid; asm volatile("" : "+v"(tid_)); const int lane_ = tid_ & 63; (void)lane_;
    const bf16* U = (const bf16*)(C.ws + WS_U); bf16* act = (bf16*)(C.ws + WS_ACT);
    const float* fw = C.ffn_conv_w + (size_t)l * 3 * NUP; const float* fb = C.ffn_conv_b + (size_t)l * NUP;
    constexpr int F8 = DFF / 8;
    const size_t total = (size_t)T * F8;
    for (size_t idx = (size_t)C.bid * 512 + tid_; idx < total; idx += (size_t)C.G * 512) {
        const int t = (int)(idx / F8), f = 8 * (int)(idx % F8);
        const int tlo = t < 16384 ? 0 : 16384 + ((t - 16384) & ~2047), thi = t < 16384 ? 16384 : tlo + 2048;
        float g[8], v[8];
#pragma unroll
        for (int i = 0; i < 8; ++i) { g[i] = fb[f + i]; v[i] = fb[DFF + f + i]; }
#pragma unroll
        for (int k = 0; k < 3; ++k) { const int tt = t + k - 1;
            if (tt >= tlo && tt < thi) { const v4u a = *(const v4u*)(U + (size_t)tt * NUP + f), b = *(const v4u*)(U + (size_t)tt * NUP + DFF + f); float fa[8], fbv[8]; unpack8(a, fa); unpack8(b, fbv);
#pragma unroll
                for (int i = 0; i < 8; ++i) { g[i] += fw[k * NUP + f + i] * fa[i]; v[i] += fw[k * NUP + DFF + f + i] * fbv[i]; } } }
        float z[8];
#pragma unroll
        for (int i = 0; i < 8; ++i) z[i] = g[i] * __builtin_amdgcn_rcpf(1.0f + __expf(-g[i])) * v[i];
        v4u o; o.x = pkbf(z[0], z[1]); o.y = pkbf(z[2], z[3]); o.z = pkbf(z[4], z[5]); o.w = pkbf(z[6], z[7]);
        *(v4u*)(act + (size_t)t * DFF + f) = o;
    }
}

__device__ __forceinline__ void phase_final(const Ctx& C) {
    int tid_ = C.tid; asm volatile("" : "+v"(tid_)); const int lane_ = tid_ & 63;
    const int gw = C.bid * 8 + C.wave, NGW = C.G * 8;
    const float* x = (const float*)(C.ws + WS_X);
    for (int r = gw; r < T; r += NGW) {
        const f32x4* s4 = (const f32x4*)(x + (size_t)r * D) + lane_; f32x4* d4 = (f32x4*)(C.out + (size_t)r * D) + lane_; const f32x4* g4 = (const f32x4*)C.final_norm_g + lane_;
        f32x4 v[8]; float ss = 0.f;
#pragma unroll
        for (int j = 0; j < 8; ++j) { v[j] = s4[64 * j]; ss += (v[j][0] * v[j][0] + v[j][1] * v[j][1]) + (v[j][2] * v[j][2] + v[j][3] * v[j][3]); }
        const float rs = rsqrtf(wave_sum(ss) * (1.0f / 2048.0f) + EPS);
#pragma unroll
        for (int j = 0; j < 8; ++j) d4[64 * j] = v[j] * rs * g4[64 * j];
    }
}

constexpr int N_PHASES = 38;
#ifndef MK_DBG_STOP
#define MK_DBG_STOP 1000
#endif
#ifndef MK_ONE_LAUNCH
#define MK_ONE_LAUNCH 0
#endif
struct Args { const float* in[15]; float* out; unsigned char* ws; int ph_lo, ph_hi, use_bar, pad; };
__global__ void __launch_bounds__(512, 2) mk_fwd(Args args) {
    extern __shared__ __attribute__((aligned(16))) unsigned char lds[];
    Ctx C;
    C.lds = (LAS unsigned char*)lds; C.tid = threadIdx.x; C.lane = C.tid & 63; C.wave = __builtin_amdgcn_readfirstlane(C.tid >> 6); C.G = gridDim.x; C.bid = blockIdx.x;
    C.x_prompt = args.in[0]; C.x_sample = args.in[1]; C.norm_mix_g = args.in[2]; C.w_in = args.in[3]; C.gate_b = args.in[4]; C.conv_w = args.in[5]; C.conv_norm_g = args.in[6]; C.mlstm_norm_g = args.in[7];
    C.w_out = args.in[8]; C.norm_ffn_g = args.in[9]; C.w_up = args.in[10]; C.ffn_conv_w = args.in[11]; C.ffn_conv_b = args.in[12]; C.w_down = args.in[13]; C.final_norm_g = args.in[14];
    C.out = args.out; C.ws = args.ws;
    volatile LAS unsigned* MISC = (volatile LAS unsigned*)(C.lds + MISC_OFF);
    if (C.tid < 64) MISC[C.tid] = 0u;
    __syncthreads();
    unsigned* barw = (unsigned*)(C.ws + WS_CTL) + CW_BAR;
    XcdBarrier bar; bar.bar = barw; bar.x = 0; bar.st = nullptr;
    if (args.use_bar) bar = xcd_barrier_post(barw, MISC + 8);
    const int lo = args.ph_lo, hi = args.ph_hi;
#define IN(k) (lo <= (k) && (k) < hi && ((k) < MK_DBG_STOP || (k) == 37))
#define SEAM(k) do { if (IN((k) + 1)) xcd_barrier(bar); } while (0)
    unsigned long long* SS = (unsigned long long*)(C.ws + WS_SUMSQ);
    bf16* XB = (bf16*)(C.ws + WS_XB);
    if (IN(0)) { phase_x0(C); SEAM(0); }
#pragma unroll 1
    for (int l = 0; l < DEPTH; ++l) {
        const int pb = 1 + 9 * l;
        if (IN(pb + 0)) { phase_w(C, l); SEAM(pb + 0); }
        if (IN(pb + 1)) {
            pg8::Gemm g{XB, (const bf16*)(C.ws + WS_W + WO_IN), T, NINP, D}; pg8::StaticOrder S; S.init(T, NINP, C.G, C.bid);
            pg8::EpiProj E{(bf16*)(C.ws + WS_PROJ), (float*)(C.ws + WS_GATES), SS + (size_t)(2 * l) * T, C.gate_b + l * 16};
            pg8::gemm_phase<pg8::EpiProj, pg8::StaticOrder, true, true>(C.lds, g, S, E);
            SEAM(pb + 1);
        }
        if (IN(pb + 2)) { phase_conv(C, l); phase_m1(C); SEAM(pb + 2); }
        if (IN(pb + 3)) { phase_m2(C); SEAM(pb + 3); }
        if (IN(pb + 4)) { phase_m3(C, l); SEAM(pb + 4); }
        if (IN(pb + 5)) {
            pg8::Gemm g{(const bf16*)(C.ws + WS_MIX), (const bf16*)(C.ws + WS_W + WO_OUT), T, D, D}; pg8::StaticOrder S; S.init(T, D, C.G, C.bid);
            pg8::EpiResid E{(float*)(C.ws + WS_X), XB, SS + (size_t)(2 * l + 1) * T};
            pg8::gemm_phase<pg8::EpiResid, pg8::StaticOrder, true, true>(C.lds, g, S, E);
            SEAM(pb + 5);
        }
        if (IN(pb + 6)) {
            pg8::Gemm g{XB, (const bf16*)(C.ws + WS_W + WO_UP), T, NUP, D}; pg8::StaticOrder S; S.init(T, NUP, C.G, C.bid);
            pg8::EpiScaleBf16 E{(bf16*)(C.ws + WS_U), NUP, SS + (size_t)(2 * l + 1) * T};
            pg8::gemm_phase<pg8::EpiScaleBf16, pg8::StaticOrder, true, true>(C.lds, g, S, E);
            SEAM(pb + 6);
        }
        if (IN(pb + 7)) { phase_glu(C, l); SEAM(pb + 7); }
        if (IN(pb + 8)) {
            pg8::Gemm g{(const bf16*)(C.ws + WS_ACT), (const bf16*)(C.ws + WS_W + WO_DOWN), T, D, DFF}; pg8::StaticOrder S; S.init(T, D, C.G, C.bid);
            pg8::EpiResid E{(float*)(C.ws + WS_X), XB, SS + (size_t)(2 * l + 2) * T};
            pg8::gemm_phase<pg8::EpiResid, pg8::StaticOrder, true, true>(C.lds, g, S, E);
            SEAM(pb + 8);
        }
    }
    if (IN(37)) phase_final(C);
#undef IN
#undef SEAM
}

extern "C" void kernel_launch(void* const* d_in, const int* in_sizes, int n_in, void* d_out, int out_size, void* d_ws, size_t ws_size, hipStream_t stream) {
    static int grid = 0;
    if (grid == 0) {
        if (n_in != 15 || out_size != T * D || ws_size < WS_END) { fprintf(stderr, "kernel_launch: unexpected shapes (n_in %d, out %d, ws %zu < %zu); nothing launched\n", n_in, out_size, ws_size, (size_t)WS_END); grid = -1; return; }
        int dev = 0, cus = 0, per_cu = 0;
        if (hipGetDevice(&dev) != hipSuccess || hipDeviceGetAttribute(&cus, hipDeviceAttributeMultiprocessorCount, dev) != hipSuccess) { grid = -1; return; }
        if (hipFuncSetAttribute((const void*)mk_fwd, hipFuncAttributeMaxDynamicSharedMemorySize, LDS_BYTES) != hipSuccess) { fprintf(stderr, "kernel_launch: hipFuncSetAttribute failed\n"); grid = -1; return; }
        if (hipOccupancyMaxActiveBlocksPerMultiprocessor(&per_cu, (const void*)mk_fwd, 512, LDS_BYTES) != hipSuccess || per_cu < 1) { fprintf(stderr, "kernel_launch: occupancy query says %d blocks per CU\n", per_cu); }
        (void)hipGetLastError();
        grid = cus;
    }
    if (grid < 0) return;
    (void)hipMemsetAsync((char*)d_ws + WS_CTL, 0, CTL_ZERO_BYTES, stream);
    Args a{};
    for (int i = 0; i < 15; ++i) a.in[i] = (const float*)d_in[i];
    a.out = (float*)d_out; a.ws = (unsigned char*)d_ws;
#if MK_ONE_LAUNCH
    a.ph_lo = 0; a.ph_hi = N_PHASES; a.use_bar = 1;
    hipLaunchKernelGGL(mk_fwd, dim3(grid), dim3(512), LDS_BYTES, stream, a);
#else
    for (int p = 0; p < N_PHASES; ++p) { a.ph_lo = p; a.ph_hi = p + 1; a.use_bar = 0; hipLaunchKernelGGL(mk_fwd, dim3(grid), dim3(512), LDS_BYTES, stream, a); }
#endif
}
```

```cpp
#include <hip/hip_runtime.h>
#include <cstdio>
#include <cstdint>
namespace pg8 {
#define PG8_LAS __attribute__((address_space(3)))
typedef unsigned short bf16_t;
typedef short bf16x8 __attribute__((ext_vector_type(8)));
typedef float f32x4 __attribute__((ext_vector_type(4)));
typedef unsigned u32x4 __attribute__((ext_vector_type(4)));
constexpr int BM = 256, BK = 64, HALF = 128, HTB = HALF * BK * 2  , STAGE_BYTES = 8 * HTB, NXCD = 8, WGM = 8;

__host__ __device__ __forceinline__ int lds_byte(int r, int c) { const int st = (r >> 4) * 2 + (c >> 5), rr = r & 15, cc = c & 31, ob = rr * 64 + cc * 2; return st * 1024 + (ob ^ (((ob >> 9) & 1) << 5)); }
__host__ __device__ __forceinline__ void stage_rc(int b, int& R, int& C) { const int st = b / 1024, sb = b % 1024, swz = sb ^ (((sb >> 9) & 1) << 5); R = (st >> 1) * 16 + swz / 64; C = (st & 1) * 32 + (swz % 64) / 2; }
__host__ __device__ __forceinline__ int perm32(int rho) { const int n = rho >> 4, i = rho & 15; return 8 * (i >> 2) + 4 * n + (i & 3); }

struct Unit { int pm, pn; };
struct Gemm { const bf16_t* A; const bf16_t* Bt; int M, N, K; };

struct StaticOrder {
    int nM, nN, nwg, G, c;
    __host__ __device__ __forceinline__ void init(int M, int N, int G_, int c_) { nM = M / BM; nN = N / BM; nwg = nM * nN; G = G_; c = c_; }
    __host__ __device__ __forceinline__ bool next(int i, Unit& u) const {
        const long L = (long)i * G + c; if (L >= nwg) return false;
        int wgid = (int)L; { const int q = nwg / NXCD, r = nwg % NXCD, xcd = wgid % NXCD, off = wgid / NXCD; wgid = (xcd < r ? xcd * (q + 1) : r * (q + 1) + (xcd - r) * q) + off; }
        const int nig = WGM * nN, gid = wgid / nig, fm = gid * WGM, gsz = (nM - fm) < WGM ? (nM - fm) : WGM;
        u.pm = fm + ((wgid % nig) % gsz); u.pn = (wgid % nig) / gsz; return true;
    }
    __device__ __forceinline__ void a_ready(const Unit&) const {}
    __device__ __forceinline__ void done(const Unit&) const {}
};

__device__ __forceinline__ unsigned cvt_pk_bf16(float lo, float hi) { unsigned r; asm volatile("v_cvt_pk_bf16_f32 %0, %1, %2" : "=v"(r) : "v"(lo), "v"(hi)); return r; }
typedef float f32x2 __attribute__((ext_vector_type(2)));
typedef unsigned u32x2 __attribute__((ext_vector_type(2)));
constexpr float RMS_EPS = 1e-6f;
__device__ __forceinline__ float rstd_of_row(const float* p) {
    f32x4 s = *(const f32x4*)p;
#pragma unroll
    for (int i = 1; i < 8; ++i) s += *(const f32x4*)(p + 4 * i);
    return rsqrtf(((s[0] + s[1]) + (s[2] + s[3])) * (1.0f / 2048.0f) + RMS_EPS);
}
struct RsTab { PG8_LAS const float* tab; int pm0, pm1, pm2, pm3; const float* ps;
    __device__ __forceinline__ int slot(int pm) const { return pm == pm0 ? 0 : pm == pm1 ? 1 : pm == pm2 ? 2 : pm == pm3 ? 3 : -1; }
    __device__ __forceinline__ void get8(int pm, int wr, int fr, float (&rs)[2][4]) const { const int sl = slot(pm);
        if (sl >= 0) { PG8_LAS const float* t = tab + sl * 256 + wr * 64 + fr;
#pragma unroll
            for (int ai = 0; ai < 2; ++ai)
#pragma unroll
                for (int m = 0; m < 4; ++m) rs[ai][m] = t[ai * HALF + m * 16]; }
        else { const float* q = ps + (size_t)(pm * BM + wr * 64 + fr) * 32;
#pragma unroll
            for (int ai = 0; ai < 2; ++ai)
#pragma unroll
                for (int m = 0; m < 4; ++m) rs[ai][m] = rstd_of_row(q + (size_t)(ai * HALF + m * 16) * 32); } } };
struct EpiProj {
    static constexpr int PERM = 3; static constexpr bool AFTER_DRAIN = false;
    bf16_t* P; float* gates; RsTab rt; const float* gate_b;
    __device__ __forceinline__ void operator()(const f32x4 (&acc)[2][2][4][2], const Unit& u, int wr, int wc, int fr, int fq) const {
        const int row0 = u.pm * BM + wr * 64 + fr; float rs8[2][4]; rt.get8(u.pm, wr, fr, rs8);
        if (u.pn < 28) {
            const int col0 = u.pn * BM + wc * 64 + 8 * fq;
#pragma unroll
            for (int ai = 0; ai < 2; ++ai)
#pragma unroll
                for (int m = 0; m < 4; ++m) { const int r = row0 + ai * HALF + m * 16; const float rs = rs8[ai][m];
                    bf16_t* rowp = P + (size_t)r * 7168 + col0;
#pragma unroll
                    for (int bj = 0; bj < 2; ++bj) { const f32x4 v0 = acc[ai][bj][m][0] * rs, v1 = acc[ai][bj][m][1] * rs;
                        u32x4 w; w.x = cvt_pk_bf16(v0[0], v0[1]); w.y = cvt_pk_bf16(v0[2], v0[3]); w.z = cvt_pk_bf16(v1[0], v1[1]); w.w = cvt_pk_bf16(v1[2], v1[3]);
                        __builtin_nontemporal_store(w, (u32x4*)(rowp + bj * 32)); } }
        } else if (wc == 0 && fq < 2) {
#pragma unroll
            for (int ai = 0; ai < 2; ++ai)
#pragma unroll
                for (int m = 0; m < 4; ++m) { const int r = row0 + ai * HALF + m * 16; const float rs = rs8[ai][m];
                    float* gp = gates + (size_t)r * 16 + 8 * fq;
#pragma unroll
                    for (int n = 0; n < 2; ++n) *(f32x4*)(gp + 4 * n) = acc[ai][0][m][n] * rs + *(const f32x4*)(gate_b + 8 * fq + 4 * n); }
        }
    }
};
#ifndef MK_RESID_LO
#define MK_RESID_LO 2
#endif
struct EpiResid {
    static constexpr int PERM = 3; static constexpr bool AFTER_DRAIN = false;
    bf16_t* xh; bf16_t* xl; float* ps; float sign; int do_ss; int rd_lo, wr_lo;
    __device__ __forceinline__ void operator()(const f32x4 (&acc)[2][2][4][2], const Unit& u, int wr, int wc, int fr, int fq) const {
        const int row0 = u.pm * BM + wr * 64 + fr, col0 = u.pn * BM + wc * 64 + 8 * fq;
#pragma unroll
        for (int ai = 0; ai < 2; ++ai) {
            u32x4 vh[4][2], vl[4][2];
#pragma unroll
            for (int m = 0; m < 4; ++m)
#pragma unroll
                for (int bj = 0; bj < 2; ++bj) { const size_t o = (size_t)(row0 + ai * HALF + m * 16) * 2048 + col0 + bj * 32; vh[m][bj] = *(const u32x4*)(xh + o);
                    if (rd_lo) vl[m][bj] = *(const u32x4*)(xl + o); else vl[m][bj] = (u32x4){0u, 0u, 0u, 0u}; }
#pragma unroll
            for (int m = 0; m < 4; ++m) { const int r = row0 + ai * HALF + m * 16; const size_t off = (size_t)r * 2048 + col0; float ss = 0.f;
#pragma unroll
                for (int bj = 0; bj < 2; ++bj) { const u32x4 h4 = vh[m][bj], l4 = vl[m][bj]; u32x4 wh, wl;
#pragma unroll
                    for (int n = 0; n < 2; ++n) { const unsigned hx = n ? h4.z : h4.x, hy = n ? h4.w : h4.y, lx = n ? l4.z : l4.x, ly = n ? l4.w : l4.y;
                        f32x4 v;
                        v[0] = __uint_as_float(hx << 16) + __uint_as_float(lx << 16); v[1] = __uint_as_float(hx & 0xffff0000u) + __uint_as_float(lx & 0xffff0000u);
                        v[2] = __uint_as_float(hy << 16) + __uint_as_float(ly << 16); v[3] = __uint_as_float(hy & 0xffff0000u) + __uint_as_float(ly & 0xffff0000u);
                        v = v + acc[ai][bj][m][n] * sign;
                        ss += (v[0] * v[0] + v[1] * v[1]) + (v[2] * v[2] + v[3] * v[3]);
                        const unsigned w0 = cvt_pk_bf16(v[0], v[1]), w1 = cvt_pk_bf16(v[2], v[3]);
                        const unsigned q0 = cvt_pk_bf16(v[0] - __uint_as_float(w0 << 16), v[1] - __uint_as_float(w0 & 0xffff0000u)), q1 = cvt_pk_bf16(v[2] - __uint_as_float(w1 << 16), v[3] - __uint_as_float(w1 & 0xffff0000u));
                        if (n == 0) { wh.x = w0; wh.y = w1; wl.x = q0; wl.y = q1; } else { wh.z = w0; wh.w = w1; wl.z = q0; wl.w = q1; } }
                    *(u32x4*)(xh + off + bj * 32) = wh;
                    if (wr_lo) *(u32x4*)(xl + off + bj * 32) = wl; }
                ss += __shfl_xor(ss, 16); ss += __shfl_xor(ss, 32);
                if (fq == 0 && do_ss) ps[(size_t)r * 32 + u.pn * 4 + wc] = ss; }
            asm volatile("" ::: "memory");
        }
    }
};
__device__ __forceinline__ float dpp_shr1(float old, float src) { return __builtin_bit_cast(float, __builtin_amdgcn_update_dpp(__builtin_bit_cast(int, old), __builtin_bit_cast(int, src), 0x111, 0xf, 0xf, false)); }
__device__ __forceinline__ float dpp_shl1(float old, float src) { return __builtin_bit_cast(float, __builtin_amdgcn_update_dpp(__builtin_bit_cast(int, old), __builtin_bit_cast(int, src), 0x101, 0xf, 0xf, false)); }
__device__ __forceinline__ float dpp_ror1(float src) { return __builtin_bit_cast(float, __builtin_amdgcn_update_dpp(0, __builtin_bit_cast(int, src), 0x121, 0xf, 0xf, false)); }
__device__ __forceinline__ float dpp_rol1(float src) { return __builtin_bit_cast(float, __builtin_amdgcn_update_dpp(0, __builtin_bit_cast(int, src), 0x12F, 0xf, 0xf, false)); }
struct EpiGlu {
    static constexpr int PERM = 1; static constexpr bool AFTER_DRAIN = false;
    static constexpr int DFF_ = 5632, NUP_ = 11264;
    bf16_t* act; float* HB; RsTab rt; const float* cw; const float* cb; PG8_LAS unsigned char* hl;
    __device__ __forceinline__ void operator()(const f32x4 (&acc)[2][2][4][2], const Unit& u, int wr, int wc, int fr, int fq) const {
        const int row0 = u.pm * BM + wr * 64 + fr, cl = wc * 32 + 8 * fq;
        float rs[2][4]; rt.get8(u.pm, wr, fr, rs);
        f32x4 pw[8];
        { const int col = u.pn * 128 + cl; pw[0] = *(const f32x4*)(cw + col); pw[1] = *(const f32x4*)(cw + NUP_ + col); pw[2] = *(const f32x4*)(cw + 2 * NUP_ + col); pw[3] = *(const f32x4*)(cb + col);
          pw[4] = *(const f32x4*)(cw + DFF_ + col); pw[5] = *(const f32x4*)(cw + NUP_ + DFF_ + col); pw[6] = *(const f32x4*)(cw + 2 * NUP_ + DFF_ + col); pw[7] = *(const f32x4*)(cb + DFF_ + col); }
        if (fr == 0 || fr == 15) {
#pragma unroll
            for (int ai = 0; ai < 2; ++ai) { const int slot = 2 * (2 * ai + wr) + (fr == 15 ? 1 : 0); const float rsv = fr == 15 ? rs[ai][3] : rs[ai][0];
#pragma unroll
                for (int bj = 0; bj < 2; ++bj)
#pragma unroll
                    for (int n = 0; n < 2; ++n) { const f32x4 a0 = fr == 15 ? acc[ai][bj][3][n] : acc[ai][bj][0][n];
                        *(PG8_LAS f32x4*)(hl + slot * 1024 + (bj * 128 + cl + 4 * n) * 4) = a0 * rsv; } }
        }
        if ((wr == 0 && fr < 2) || (wr == 1 && fr >= 14)) {
            const int ai = wr, rowslot = wr ? (fr - 12) : fr;
            float* hb = HB + (size_t)(u.pm * 4 + rowslot) * NUP_ + u.pn * 128 + cl;
#pragma unroll
            for (int bj = 0; bj < 2; ++bj)
#pragma unroll
                for (int n = 0; n < 2; ++n) { const f32x4 a0 = ai ? acc[1][bj][3][n] : acc[0][bj][0][n]; *(f32x4*)(hb + bj * DFF_ + 4 * n) = a0 * (ai ? rs[1][3] : rs[0][0]); }
        }
        asm volatile("s_waitcnt lgkmcnt(0)" ::: "memory"); __builtin_amdgcn_s_barrier(); asm volatile("" ::: "memory");
        u32x2 keep[2][4];
#pragma unroll
        for (int n = 0; n < 2; ++n) {
            const int col = u.pn * 128 + cl + 4 * n;
            const f32x4 w0g = n ? *(const f32x4*)(cw + col) : pw[0], w1g = n ? *(const f32x4*)(cw + NUP_ + col) : pw[1], w2g = n ? *(const f32x4*)(cw + 2 * NUP_ + col) : pw[2], bg = n ? *(const f32x4*)(cb + col) : pw[3];
            const f32x4 w0v = n ? *(const f32x4*)(cw + DFF_ + col) : pw[4], w1v = n ? *(const f32x4*)(cw + NUP_ + DFF_ + col) : pw[5], w2v = n ? *(const f32x4*)(cw + 2 * NUP_ + DFF_ + col) : pw[6], bv = n ? *(const f32x4*)(cb + DFF_ + col) : pw[7];
#pragma unroll
            for (int ai = 0; ai < 2; ++ai) {
                const int sg = 2 * ai + wr;
                f32x4 Ug[4], Uv[4];
#pragma unroll
                for (int m = 0; m < 4; ++m) { Ug[m] = acc[ai][0][m][n] * rs[ai][m]; Uv[m] = acc[ai][1][m][n] * rs[ai][m]; }
                f32x4 hug = (f32x4){0.f, 0.f, 0.f, 0.f}, huv = hug, hdg = hug, hdv = hug;
                if (sg > 0) { PG8_LAS const unsigned char* p = hl + (2 * (sg - 1) + 1) * 1024 + (cl + 4 * n) * 4; hug = *(PG8_LAS const f32x4*)p; huv = *(PG8_LAS const f32x4*)(p + 512); }
                if (sg < 3) { PG8_LAS const unsigned char* p = hl + (2 * (sg + 1)) * 1024 + (cl + 4 * n) * 4;     hdg = *(PG8_LAS const f32x4*)p; hdv = *(PG8_LAS const f32x4*)(p + 512); }
#pragma unroll
                for (int m = 0; m < 4; ++m) {
                    float z[4];
#pragma unroll
                    for (int j = 0; j < 4; ++j) {
                        const float sug = m > 0 ? dpp_ror1(Ug[m - 1][j]) : hug[j], suv = m > 0 ? dpp_ror1(Uv[m - 1][j]) : huv[j];
                        const float sdg = m < 3 ? dpp_rol1(Ug[m + 1][j]) : hdg[j], sdv = m < 3 ? dpp_rol1(Uv[m + 1][j]) : hdv[j];
                        const float upg = dpp_shr1(sug, Ug[m][j]), dng = dpp_shl1(sdg, Ug[m][j]), upv = dpp_shr1(suv, Uv[m][j]), dnv = dpp_shl1(sdv, Uv[m][j]);
                        const float g = bg[j] + w0g[j] * upg + w1g[j] * Ug[m][j] + w2g[j] * dng, vv = bv[j] + w0v[j] * upv + w1v[j] * Uv[m][j] + w2v[j] * dnv;
                        z[j] = g * __builtin_amdgcn_rcpf(1.0f + __expf(-g)) * vv;
                    }
                    u32x2 w; w.x = cvt_pk_bf16(z[0], z[1]); w.y = cvt_pk_bf16(z[2], z[3]);
                    if (n == 0) keep[ai][m] = w;
                    else { u32x4 o; o.x = keep[ai][m].x; o.y = keep[ai][m].y; o.z = w.x; o.w = w.y; __builtin_nontemporal_store(o, (u32x4*)(act + (size_t)(row0 + ai * HALF + m * 16) * DFF_ + u.pn * 128 + cl)); }
                }
            }
        }
    }
};
template <class Epi, class Sched, bool ALIGN_EPI = false, bool SP2 = false>
__device__ __forceinline__ void gemm_phase(PG8_LAS unsigned char* lds, const Gemm g, const Sched& S, const Epi& E, unsigned long long* tim = nullptr) {
    int tid = threadIdx.x; asm volatile("" : "+v"(tid));
    const int wid = __builtin_amdgcn_readfirstlane(tid >> 6), lane = tid & 63, wr = wid >> 2, wc = wid & 3, fr = lane & 15, fq = lane >> 4;
    const int K = g.K, nt = K / BK;
    unsigned voffA[2], voffB[2];
#pragma unroll
    for (int i = 0; i < 2; ++i) { int R, C; stage_rc(tid * 16 + i * 8192, R, C);
        const int Rb = (int)Epi::PERM == 3 ? (64 * (R >> 5) + 8 * ((R & 15) >> 2) + 4 * ((R >> 4) & 1) + (R & 3)) : (int)Epi::PERM == 2 ? (64 * (R >> 5) + 16 * ((R & 15) >> 2) + 4 * ((R >> 4) & 1) + (R & 3)) : ((int)Epi::PERM == 1 ? ((R & ~31) + perm32(R & 31)) : R);
        voffA[i] = (unsigned)(R * K + C) * 2u; voffB[i] = (unsigned)(Rb * K + C) * 2u; }
    const size_t kstep = (size_t)(BK * 2);
    const size_t hstep = (size_t)HALF * K * 2;
    const size_t hstepB = (int)Epi::PERM == 3 ? (size_t)32 * K * 2 : (int)Epi::PERM == 2 ? (size_t)8 * K * 2 : hstep;
    const size_t tstep = 2 * hstep;
    const unsigned ldsw = (unsigned)wid * 1024u;
    const int aoff = lds_byte(wr * 64 + fr, fq * 8), boff = lds_byte(wc * 32 + fr, fq * 8);
#define PG8_SA(b, h) (((b) * 2 + (h)) * HTB)
#define PG8_SB(b, h) ((4 + (b) * 2 + (h)) * HTB)
#define PG8_STAGE(bufoff, gbase, voff) do { _Pragma("unroll") for (int _i = 0; _i < 2; ++_i) \
        __builtin_amdgcn_global_load_lds((const unsigned*)((const char*)(gbase) + (voff)[_i]), (PG8_LAS unsigned*)(lds + (bufoff) + ldsw + _i * 8192), 16, 0, 0); } while (0)
#define PG8_LDA(dst, b, h) do { _Pragma("unroll") for (int m = 0; m < 4; ++m) _Pragma("unroll") for (int k = 0; k < 2; ++k) dst[m][k] = *(const PG8_LAS bf16x8*)(lds + PG8_SA(b, h) + aoff + m * 2048 + k * 1024); } while (0)
#define PG8_LDB(dst, b, h) do { _Pragma("unroll") for (int n = 0; n < 2; ++n) _Pragma("unroll") for (int k = 0; k < 2; ++k) dst[n][k] = *(const PG8_LAS bf16x8*)(lds + PG8_SB(b, h) + boff + n * 2048 + k * 1024); } while (0)
#define PG8_MMA(ai, bj, At, Bt) do { __builtin_amdgcn_s_setprio(1); _Pragma("unroll") for (int m = 0; m < 4; ++m) _Pragma("unroll") for (int n = 0; n < 2; ++n) _Pragma("unroll") for (int k = 0; k < 2; ++k) \
        acc[ai][bj][m][n] = __builtin_amdgcn_mfma_f32_16x16x32_bf16(Bt[n][k], At[m][k], acc[ai][bj][m][n], 0, 0, 0); __builtin_amdgcn_s_setprio(0); } while (0)
#define PG8_WAIT_V(n) asm volatile("s_waitcnt vmcnt(" #n ")" ::: "memory")
#define PG8_WAIT_L(n) asm volatile("s_waitcnt lgkmcnt(" #n ")" ::: "memory")
#define PG8_BAR __builtin_amdgcn_s_barrier()
#define PG8_SCHED __builtin_amdgcn_sched_barrier(0)
    Unit cur, nxt; int ui = 0;
    if (!S.next(0, cur)) return;
    f32x4 acc[2][2][4][2];
#pragma unroll
    for (int a = 0; a < 2; ++a)
#pragma unroll
        for (int b = 0; b < 2; ++b)
#pragma unroll
            for (int m = 0; m < 4; ++m)
#pragma unroll
                for (int n = 0; n < 2; ++n) acc[a][b][m][n] = (f32x4){0.f, 0.f, 0.f, 0.f};
    bf16x8 At[4][2], B0[2][2], B1[2][2];
    const char* cA = (const char*)g.A + (size_t)cur.pm * tstep; const char* cB = (const char*)g.Bt + (size_t)cur.pn * tstep;
    S.a_ready(cur);
    if constexpr (SP2) {
        PG8_STAGE(PG8_SB(0, 0), cB, voffB); PG8_STAGE(PG8_SB(0, 1), cB + hstepB, voffB); PG8_STAGE(PG8_SA(0, 0), cA, voffA); PG8_STAGE(PG8_SA(0, 1), cA + hstep, voffA);
        if (wr == 1) PG8_BAR;
        PG8_WAIT_V(2); PG8_BAR;
        PG8_STAGE(PG8_SB(1, 0), cB + kstep, voffB); PG8_STAGE(PG8_SA(1, 0), cA + kstep, voffA); PG8_STAGE(PG8_SB(1, 1), cB + hstepB + kstep, voffB);
        PG8_WAIT_V(6); PG8_BAR;
    } else {
        PG8_STAGE(PG8_SB(0, 0), cB, voffB); PG8_STAGE(PG8_SA(0, 0), cA, voffA); PG8_STAGE(PG8_SB(0, 1), cB + hstepB, voffB); PG8_STAGE(PG8_SA(0, 1), cA + hstep, voffA);
        if (wr == 1) PG8_BAR;
        PG8_WAIT_V(4); PG8_BAR;
        PG8_STAGE(PG8_SB(1, 0), cB + kstep, voffB); PG8_STAGE(PG8_SA(1, 0), cA + kstep, voffA); PG8_STAGE(PG8_SB(1, 1), cB + hstepB + kstep, voffB);
        PG8_WAIT_V(6); PG8_BAR;
    }
    if (tim) { tim[2] = __builtin_amdgcn_s_memrealtime(); asm volatile("s_waitcnt lgkmcnt(0)" ::: "memory"); }
    for (;;) {
        const bool has_next = S.next(ui + 1, nxt);
        const char* nA = has_next ? (const char*)g.A + (size_t)nxt.pm * tstep : cA; const char* nB = has_next ? (const char*)g.Bt + (size_t)nxt.pn * tstep : cB;
        for (int t = 0; t < nt; t += 2) {
            const bool last = (t == nt - 2);
            const char* a1 = cA + (size_t)(t + 1) * kstep;
            const char* a2 = last ? nA : cA + (size_t)(t + 2) * kstep; const char* b2 = last ? nB : cB + (size_t)(t + 2) * kstep;
            const char* a3 = a2 + kstep; const char* b3 = b2 + kstep;
            if (last && has_next) S.a_ready(nxt);
            if constexpr (SP2) {
            PG8_LDB(B0, 0, 0); PG8_LDB(B1, 0, 1); PG8_SCHED; PG8_LDA(At, 0, 0); PG8_STAGE(PG8_SA(1, 1), a1 + hstep, voffA);
            PG8_WAIT_V(8); PG8_WAIT_L(0); PG8_BAR; PG8_MMA(0, 0, At, B0); PG8_MMA(0, 1, At, B1); PG8_BAR; PG8_SCHED;
            PG8_LDA(At, 0, 1); PG8_STAGE(PG8_SB(0, 0), b2, voffB); PG8_STAGE(PG8_SB(0, 1), b2 + hstepB, voffB); PG8_STAGE(PG8_SA(0, 0), a2, voffA);
            PG8_WAIT_V(8); PG8_WAIT_L(0); PG8_BAR; PG8_MMA(1, 0, At, B0); PG8_MMA(1, 1, At, B1); PG8_BAR; PG8_SCHED;
            PG8_LDB(B0, 1, 0); PG8_LDB(B1, 1, 1); PG8_SCHED; PG8_LDA(At, 1, 0); PG8_STAGE(PG8_SA(0, 1), a2 + hstep, voffA);
            PG8_WAIT_V(8); PG8_WAIT_L(0); PG8_BAR; PG8_MMA(0, 0, At, B0); PG8_MMA(0, 1, At, B1); PG8_BAR; PG8_SCHED;
            PG8_LDA(At, 1, 1); PG8_STAGE(PG8_SB(1, 0), b3, voffB); PG8_STAGE(PG8_SB(1, 1), b3 + hstepB, voffB); PG8_STAGE(PG8_SA(1, 0), a3, voffA);
            PG8_WAIT_V(8); PG8_WAIT_L(0); PG8_BAR; PG8_MMA(1, 0, At, B0); PG8_MMA(1, 1, At, B1); PG8_BAR; PG8_SCHED;
            } else {
            PG8_LDB(B0, 0, 0); PG8_SCHED; PG8_LDA(At, 0, 0); PG8_STAGE(PG8_SA(1, 1), a1 + hstep, voffA);
            PG8_WAIT_L(8); PG8_BAR; PG8_WAIT_L(0); PG8_MMA(0, 0, At, B0); PG8_BAR; PG8_SCHED;
            PG8_LDB(B1, 0, 1); PG8_STAGE(PG8_SB(0, 0), b2, voffB);
            PG8_BAR; PG8_WAIT_L(0); PG8_MMA(0, 1, At, B1); PG8_BAR;
            PG8_LDA(At, 0, 1); PG8_STAGE(PG8_SA(0, 0), a2, voffA);
            PG8_BAR; PG8_WAIT_L(0); PG8_MMA(1, 0, At, B0); PG8_BAR; PG8_SCHED;
            PG8_STAGE(PG8_SB(0, 1), b2 + hstepB, voffB);
            PG8_WAIT_V(6); PG8_BAR; PG8_MMA(1, 1, At, B1); PG8_BAR;
            PG8_LDB(B0, 1, 0); PG8_SCHED; PG8_LDA(At, 1, 0); PG8_STAGE(PG8_SA(0, 1), a2 + hstep, voffA);
            PG8_WAIT_L(8); PG8_BAR; PG8_WAIT_L(0); PG8_MMA(0, 0, At, B0); PG8_BAR; PG8_SCHED;
            PG8_LDB(B1, 1, 1); PG8_STAGE(PG8_SB(1, 0), b3, voffB);
            PG8_BAR; PG8_WAIT_L(0); PG8_MMA(0, 1, At, B1); PG8_BAR;
            PG8_LDA(At, 1, 1); PG8_STAGE(PG8_SA(1, 0), a3, voffA);
            PG8_BAR; PG8_WAIT_L(0); PG8_MMA(1, 0, At, B0); PG8_BAR; PG8_SCHED;
            PG8_STAGE(PG8_SB(1, 1), b3 + hstepB, voffB);
            PG8_WAIT_V(6); PG8_BAR; PG8_MMA(1, 1, At, B1); PG8_BAR;
            }
        }
        if constexpr (ALIGN_EPI) { if (wr == 0) PG8_BAR; }
        unsigned long long ts_ = 0ull; if (tim) { ts_ = __builtin_amdgcn_s_memrealtime(); asm volatile("s_waitcnt lgkmcnt(0)" ::: "memory"); tim[0] += ts_ - tim[2]; }
        if constexpr (!Epi::AFTER_DRAIN) { E(acc, cur, wr, wc, fr, fq); S.done(cur); }
        if (tim) { const unsigned long long te_ = __builtin_amdgcn_s_memrealtime(); asm volatile("s_waitcnt lgkmcnt(0)" ::: "memory"); tim[1] += te_ - ts_; tim[2] = te_; }
        if (!has_next) break;
#pragma unroll
        for (int a = 0; a < 2; ++a)
#pragma unroll
            for (int b = 0; b < 2; ++b)
#pragma unroll
                for (int m = 0; m < 4; ++m)
#pragma unroll
                    for (int n = 0; n < 2; ++n) acc[a][b][m][n] = (f32x4){0.f, 0.f, 0.f, 0.f};
        cur = nxt; cA = nA; cB = nB; ++ui;
        if constexpr (ALIGN_EPI) { if (wr == 1) PG8_BAR; }
    }
    PG8_WAIT_V(0);
    if constexpr (!ALIGN_EPI) { if (wr == 0) PG8_BAR; }
    PG8_BAR;
    if constexpr (Epi::AFTER_DRAIN) { E.fused(acc, cur, wr, wc, fr, fq, lds, wid, lane); S.done(cur); }
#undef PG8_SA
#undef PG8_SB
#undef PG8_STAGE
#undef PG8_LDA
#undef PG8_LDB
#undef PG8_MMA
#undef PG8_WAIT_V
#undef PG8_WAIT_L
#undef PG8_BAR
#undef PG8_SCHED
}
}
#define GAS __attribute__((address_space(1)))
#define LAS __attribute__((address_space(3)))
typedef unsigned short bf16;
typedef unsigned v4u __attribute__((ext_vector_type(4)));
typedef float f32x4 __attribute__((ext_vector_type(4)));
typedef short bf16x8 __attribute__((ext_vector_type(8)));
typedef GAS unsigned gu32;
typedef GAS unsigned long long gu64;
#define RLX_AGENT __ATOMIC_RELAXED, __HIP_MEMORY_SCOPE_AGENT
#define LDS_WAIT() asm volatile("s_waitcnt lgkmcnt(0)" ::: "memory")
#define VM_WAIT() asm volatile("s_waitcnt vmcnt(0)" ::: "memory")
__device__ __forceinline__ unsigned long long rt() { return __builtin_amdgcn_s_memrealtime(); }
__device__ __forceinline__ unsigned f2bf(float f) { unsigned u = __builtin_bit_cast(unsigned, f); return (u + 0x7fffu + ((u >> 16) & 1u)) >> 16; }
__device__ __forceinline__ unsigned pk2(float lo, float hi) { return f2bf(lo) | (f2bf(hi) << 16); }

#define XB_TMO      128
#define XB_XCNT(j)  (256  + 64 * (j))
#define XB_XSUB(j)  (1280 + 64 * (j))
#define XB_XGEN(j)  (2304 + 64 * (j))
#define XB_TOP      3328
#define XB_TOPGEN   3392
#define XCD_BAR_WORDS 3456
#define XB_SPIN_CAP (1u << 18)

__device__ __forceinline__ unsigned xb_ld(unsigned* p)              { return __hip_atomic_load(p, __ATOMIC_RELAXED, __HIP_MEMORY_SCOPE_AGENT); }
__device__ __forceinline__ unsigned xb_add(unsigned* p, unsigned v) { return __hip_atomic_fetch_add(p, v, __ATOMIC_RELAXED, __HIP_MEMORY_SCOPE_AGENT); }
__device__ __forceinline__ unsigned xb_xcc_id() { return (unsigned)__builtin_amdgcn_s_getreg((3 << 11) | 20) & 0xFu; }
#define XB_SPIN(cond, bar) do { unsigned _sp = 0; while (cond) { __builtin_amdgcn_s_sleep(1); \
    if ((++_sp & 255u) == 0u) { if (xb_ld(&(bar)[XB_TMO])) break; if (_sp > XB_SPIN_CAP) { atomicAdd(&(bar)[XB_TMO], 1u); break; } } } } while (0)

struct XcdBarrier {
    unsigned* bar; unsigned x;
    volatile LAS unsigned* st;
};

__device__ __forceinline__ XcdBarrier xcd_barrier_post(unsigned* bar, volatile LAS unsigned* st) {
    XcdBarrier b; b.bar = bar; b.x = xb_xcc_id(); b.st = st;
    if (threadIdx.x == 0) (void)xb_add(&bar[XB_XCNT(b.x)], 1u);
    return b;
}
__device__ __forceinline__ void xcd_barrier_complete(unsigned* bar, unsigned x, unsigned& nloc, unsigned& nx) {
    const unsigned G = gridDim.x * gridDim.y * gridDim.z;
    unsigned sum, cnt, mine, sp = 0u;
    for (;;) {
        sum = 0u; cnt = 0u; mine = 0u;
#pragma unroll
        for (unsigned j = 0; j < 16; ++j) { const unsigned c = xb_ld(&bar[XB_XCNT(j)]); sum += c; cnt += (c > 0u) ? 1u : 0u; mine = (j == x) ? c : mine; }
        if (sum == G) break;
        __builtin_amdgcn_s_sleep(1);
        if ((++sp & 255u) == 0u) { if (xb_ld(&bar[XB_TMO])) break; if (sp > XB_SPIN_CAP) { atomicAdd(&bar[XB_TMO], 1u); break; } }
    }
    nloc = mine > 0u ? mine : 1u; nx = cnt > 0u ? cnt : 1u;
}

__device__ __forceinline__ void xcd_barrier(const XcdBarrier& b) {
    asm volatile("s_waitcnt vmcnt(0)" ::: "memory");
    __syncthreads();
    if (threadIdx.x == 0) {
        unsigned* bar = b.bar;
        __builtin_amdgcn_s_waitcnt(0);
        unsigned nloc = b.st[0], nx = b.st[1];
        if (nloc == 0u) { xcd_barrier_complete(bar, b.x, nloc, nx); b.st[0] = nloc; b.st[1] = nx; }
        const unsigned old = xb_add(&bar[XB_XSUB(b.x)], 1u);
        const unsigned gen = old / nloc;
        if (old + 1u == (gen + 1u) * nloc) {
            __builtin_amdgcn_fence(__ATOMIC_RELEASE, "agent");
            asm volatile("s_waitcnt vmcnt(0)" ::: "memory");
            const unsigned og = xb_add(&bar[XB_TOP], 1u);
            const unsigned tg = og / nx;
            if (og + 1u == (tg + 1u) * nx) xb_add(&bar[XB_TOPGEN], 1u);
            else XB_SPIN(xb_ld(&bar[XB_TOPGEN]) == tg, bar);
            __builtin_amdgcn_fence(__ATOMIC_ACQUIRE, "agent");
            xb_add(&bar[XB_XGEN(b.x)], 1u);
            asm volatile("s_waitcnt vmcnt(0)" ::: "memory");
        } else {
            XB_SPIN(xb_ld(&bar[XB_XGEN(b.x)]) == gen, bar);
            __builtin_amdgcn_fence(__ATOMIC_ACQUIRE, "agent");
            asm volatile("s_waitcnt vmcnt(0)" ::: "memory");
        }
    }
    __syncthreads();
}
constexpr int T = 24576, D = 2048, DEPTH = 4, NIN = 7184, NINP = 7424, PROJW = 7168, DFF = 5632, NUP = 11264;
constexpr int NCHUNK = 192;
constexpr float EPS = 1e-6f;
constexpr size_t MiB = 1u << 20;
constexpr size_t WS_CTL = 0, CTL_ZERO_BYTES = 1 * MiB;
constexpr size_t WS_W = 3 * MiB, W_BUF = 103 * MiB;
constexpr size_t WO_IN = 0, WO_OUT = (size_t)NINP * D * 2, WO_UP = WO_OUT + (size_t)D * D * 2, WO_DOWN = WO_UP + (size_t)NUP * D * 2;
constexpr size_t WS_X = 209 * MiB;
constexpr size_t WS_XB = 401 * MiB;
constexpr size_t WS_PROJ = 497 * MiB;
constexpr size_t WS_S = 833 * MiB;
constexpr size_t WS_MIX = 1025 * MiB;
constexpr size_t WS_ACT = 1025 * MiB;
constexpr size_t WS_SM = 1289 * MiB;
constexpr size_t WS_GATES = WS_SM, WS_BQ = WS_SM + 2 * MiB, WS_BK = WS_SM + 3 * MiB, WS_KMAX = WS_SM + 4 * MiB, WS_BLAST = WS_KMAX + 8192, WS_US = WS_KMAX + 16384, WS_DN = WS_SM + 5 * MiB;
constexpr size_t WS_HB = 1297 * MiB;
constexpr size_t WS_PS = 1315 * MiB;
constexpr size_t WS_END = 1344 * MiB;
static_assert(WO_DOWN + (size_t)D * DFF * 2 <= W_BUF && WS_W + 2 * W_BUF <= WS_X && WS_PS + (size_t)9 * T * 32 * 4 <= WS_END && WS_X + (size_t)T * D * 4 <= WS_XB && WS_XB + (size_t)T * D * 2 <= WS_PROJ, "ws map 1");
static_assert(WS_PROJ + (size_t)T * PROJW * 2 <= WS_S && WS_S + (size_t)1536 * 65536 * 2 <= WS_MIX && WS_ACT + (size_t)T * DFF * 2 <= WS_SM && WS_SM + 8 * MiB <= WS_HB && WS_HB + (size_t)96 * 4 * NUP * 4 <= WS_END, "ws map 2");
constexpr int CW_BAR = 4096;
constexpr int LDS_BYTES = 152576, MISC_OFF = LDS_BYTES - 256, HALO_OFF = 131072, RST_OFF = 147456;
constexpr int TPITCH = 528;
constexpr int VT_OFF = 0, KT_OFF = 128 * TPITCH, SC_OFF = 2 * 128 * TPITCH;
static_assert(SC_OFF + 4096 <= MISC_OFF, "lds map");

typedef short bf16x8 __attribute__((ext_vector_type(8)));
typedef short s16x4 __attribute__((ext_vector_type(4)));
typedef unsigned u32x2 __attribute__((ext_vector_type(2)));
__device__ __forceinline__ float bf2f(unsigned short b) { return __uint_as_float(((unsigned)b) << 16); }
__device__ __forceinline__ unsigned pkbf(float lo, float hi) { return pg8::cvt_pk_bf16(lo, hi); }
__device__ __forceinline__ float wave_sum(float v) {
#pragma unroll
    for (int o = 1; o < 64; o <<= 1) v += __shfl_xor(v, o);
    return v;
}
__device__ __forceinline__ s16x4 tr16(LAS const unsigned char* p) { typedef short v4i16_t __attribute__((ext_vector_type(4))); return __builtin_bit_cast(s16x4, __builtin_amdgcn_ds_read_tr16_b64_v4i16((LAS v4i16_t*)p)); }
__device__ __forceinline__ bf16x8 cat8(s16x4 a, s16x4 b) { bf16x8 r; r[0] = a[0]; r[1] = a[1]; r[2] = a[2]; r[3] = a[3]; r[4] = b[0]; r[5] = b[1]; r[6] = b[2]; r[7] = b[3]; return r; }
typedef __amdgpu_buffer_rsrc_t rsrc_t;
__device__ __forceinline__ rsrc_t mkrsrc(const void* base, unsigned nbytes) {
    const unsigned long long b = (unsigned long long)base; const unsigned lo = __builtin_amdgcn_readfirstlane((unsigned)b), hi = __builtin_amdgcn_readfirstlane((unsigned)(b >> 32));
    return __builtin_amdgcn_make_buffer_rsrc((void*)(((unsigned long long)hi << 32) | lo), 0, nbytes, 0x00020000); }
__device__ __forceinline__ v4u bld128(rsrc_t rs, unsigned voff, unsigned soff) { return __builtin_amdgcn_raw_buffer_load_b128(rs, voff, soff, 0); }
__device__ __forceinline__ u32x2 bld64(rsrc_t rs, unsigned voff, unsigned soff) { return __builtin_amdgcn_raw_buffer_load_b64(rs, voff, soff, 0); }
__device__ __forceinline__ void bst64(u32x2 v, rsrc_t rs, unsigned voff, unsigned soff) { __builtin_amdgcn_raw_buffer_store_b64(v, rs, voff, soff, 0); }
__device__ __forceinline__ int unit_of(int dir, int cg, int h) { return (dir * NCHUNK + cg) * 4 + h; }

struct Ctx {
    LAS unsigned char* lds; int tid, lane, wave, G, bid;
    const float *x_prompt, *x_sample, *norm_mix_g, *w_in, *gate_b, *conv_w, *conv_norm_g, *mlstm_norm_g, *w_out, *norm_ffn_g, *w_up, *ffn_conv_w, *ffn_conv_b, *w_down, *final_norm_g;
    float* out; unsigned char* ws;
};

__device__ __forceinline__ void phase_x0(const Ctx& C) {
    int tid_ = C.tid; asm volatile("" : "+v"(tid_)); const int lane_ = tid_ & 63;
    const int gw = C.bid * 8 + C.wave, NGW = C.G * 8;
    bf16* xl = (bf16*)(C.ws + WS_X); bf16* xh = (bf16*)(C.ws + WS_XB); float* ps0 = (float*)(C.ws + WS_PS);
    f32x4 v[8];
    if (gw < T) { const float* src = gw < 16384 ? C.x_prompt + (size_t)gw * D : C.x_sample + (size_t)(gw - 16384) * D; const f32x4* s4 = (const f32x4*)src + lane_;
#pragma unroll
        for (int j = 0; j < 8; ++j) v[j] = s4[64 * j]; }
    for (int r = gw; r < T; r += NGW) {
        f32x4 vn[8]; const int rn = r + NGW;
        if (rn < T) { const float* src = rn < 16384 ? C.x_prompt + (size_t)rn * D : C.x_sample + (size_t)(rn - 16384) * D; const f32x4* s4 = (const f32x4*)src + lane_;
#pragma unroll
            for (int j = 0; j < 8; ++j) vn[j] = s4[64 * j]; }
        float ss = 0.f;
#pragma unroll
        for (int j = 0; j < 8; ++j) ss += (v[j][0] * v[j][0] + v[j][1] * v[j][1]) + (v[j][2] * v[j][2] + v[j][3] * v[j][3]);
        ss = wave_sum(ss);
        u32x2* h2 = (u32x2*)(xh + (size_t)r * D) + lane_; u32x2* l2 = (u32x2*)(xl + (size_t)r * D) + lane_;
#pragma unroll
        for (int j = 0; j < 8; ++j) { u32x2 wh; wh.x = pkbf(v[j][0], v[j][1]); wh.y = pkbf(v[j][2], v[j][3]);
            u32x2 wl; wl.x = pkbf(v[j][0] - __uint_as_float(wh.x << 16), v[j][1] - __uint_as_float(wh.x & 0xffff0000u)); wl.y = pkbf(v[j][2] - __uint_as_float(wh.y << 16), v[j][3] - __uint_as_float(wh.y & 0xffff0000u));
            h2[64 * j] = wh; if (MK_RESID_LO) l2[64 * j] = wl; }
        if (lane_ < 32) ps0[(size_t)r * 32 + lane_] = lane_ == 0 ? ss : 0.f;
        if (rn < T) {
#pragma unroll
            for (int j = 0; j < 8; ++j) v[j] = vn[j]; }
    }
}

__device__ __forceinline__ void tr_item(const float* W, int K, int Npad, int Nsrc, bf16* WT, const float* gain, int qlo, int qhi, bool permup, LAS float* scr, int item, int lane) {
    const int nblk = Npad / 32, kb = item / nblk, nb = item % nblk, k0 = 64 * kb, n0 = 32 * nb;
    const int n = (permup ? ((n0 >> 7) & 1) * DFF + 128 * (n0 >> 8) + (n0 & 127) : n0) + (lane & 31); const float cs = (n >= qlo && n < qhi) ? 0.0625f : 1.0f;
    float wv[32];
#pragma unroll
    for (int i = 0; i < 32; ++i) { const int kk = 2 * i + (lane >> 5); wv[i] = (n < Nsrc) ? W[(size_t)(k0 + kk) * Nsrc + n] : 0.f; }
#pragma unroll
    for (int i = 0; i < 32; ++i) { const int kk = 2 * i + (lane >> 5); float w = wv[i]; if (gain) w *= gain[k0 + kk]; scr[kk * 33 + (lane & 31)] = w * cs; }
    asm volatile("s_waitcnt lgkmcnt(0)" ::: "memory");
    const int c = lane & 7;
#pragma unroll
    for (int j = 0; j < 4; ++j) { const int nn = (lane >> 3) + 8 * j; const LAS float* s = scr + (8 * c) * 33 + nn;
        v4u o; o.x = pkbf(s[0 * 33], s[1 * 33]); o.y = pkbf(s[2 * 33], s[3 * 33]); o.z = pkbf(s[4 * 33], s[5 * 33]); o.w = pkbf(s[6 * 33], s[7 * 33]);
        *(v4u*)(WT + (size_t)(n0 + nn) * K + k0 + 8 * c) = o; }
    asm volatile("s_waitcnt lgkmcnt(0)" ::: "memory");
}
__device__ __forceinline__ void phase_w(const Ctx& C, int l, int part = 0) {
    int tid_ = C.tid; asm volatile("" : "+v"(tid_)); const int lane_ = tid_ & 63; (void)lane_;
    LAS float* scr = (LAS float*)(C.lds + C.wave * 16384);
    if (part == 1 && C.bid < 128) return;
    const int gw = (part == 1 ? C.bid - 128 : C.bid) * 8 + C.wave, NGW = (part == 1 ? 128 : C.G) * 8;
    constexpr int I_IN = (D / 64) * (NINP / 32), I_OUT = (D / 64) * (D / 32), I_UP = (D / 64) * (NUP / 32), I_DOWN = (DFF / 64) * (D / 32);
    constexpr int NITEMS = I_IN + I_OUT + I_UP + I_DOWN;
    bf16* wb = (bf16*)(C.ws + WS_W + (size_t)(l & 1) * W_BUF);
    constexpr int W_SPLIT = (NITEMS * 11 / 20) & ~7;
    const int it_lo = part == 2 ? W_SPLIT : 0, it_hi = part == 1 ? W_SPLIT : NITEMS;
    for (int it = it_lo + gw; it < it_hi; it += NGW) {
        int r = it;
        if (r < I_IN) { tr_item(C.w_in + (size_t)l * D * NIN, D, NINP, NIN, (bf16*)((unsigned char*)wb + WO_IN), C.norm_mix_g + l * D, 3072, 4096, false, scr, r, lane_); continue; } r -= I_IN;
        if (r < I_OUT) { tr_item(C.w_out + (size_t)l * D * D, D, D, D, (bf16*)((unsigned char*)wb + WO_OUT), nullptr, 0, 0, false, scr, r, lane_); continue; } r -= I_OUT;
        if (r < I_UP) { tr_item(C.w_up + (size_t)l * D * NUP, D, NUP, NUP, (bf16*)((unsigned char*)wb + WO_UP), C.norm_ffn_g + l * D, 0, 0, true, scr, r, lane_); continue; } r -= I_UP;
        tr_item(C.w_down + (size_t)l * DFF * D, DFF, D, D, (bf16*)((unsigned char*)wb + WO_DOWN), nullptr, 0, 0, false, scr, r, lane_);
    }
}

__device__ __forceinline__ void unpack8(const v4u& w, float (&f)[8]) {
    f[0] = __uint_as_float(w.x << 16); f[1] = __uint_as_float(w.x & 0xffff0000u); f[2] = __uint_as_float(w.y << 16); f[3] = __uint_as_float(w.y & 0xffff0000u);
    f[4] = __uint_as_float(w.z << 16); f[5] = __uint_as_float(w.z & 0xffff0000u); f[6] = __uint_as_float(w.w << 16); f[7] = __uint_as_float(w.w & 0xffff0000u);
}
__device__ __forceinline__ void conv_loads(const bf16* proj, int t0, int c0, v4u (&a)[4][2], v4u (&b)[4][2], v4u (&cbv)[2][2]) {
    const int tlo = t0 < 16384 ? 0 : 16384 + ((t0 - 16384) & ~2047), thi = t0 < 16384 ? 16384 : tlo + 2048;
#pragma unroll
    for (int r = 0; r < 4; ++r) { const int tt = t0 - 1 + r; const bool ok = tt >= tlo && tt < thi; const bf16* rp = proj + (size_t)(ok ? tt : t0) * PROJW + c0;
#pragma unroll
        for (int hh = 0; hh < 2; ++hh) { a[r][hh] = *(const v4u*)(rp + 1024 + 8 * hh); b[r][hh] = *(const v4u*)(rp + 2048 + 8 * hh); if (!ok) { a[r][hh].x = 0u; a[r][hh].y = 0u; a[r][hh].z = 0u; a[r][hh].w = 0u; } } }
#pragma unroll
    for (int k = 0; k < 2; ++k)
#pragma unroll
        for (int hh = 0; hh < 2; ++hh) cbv[k][hh] = *(const v4u*)(proj + (size_t)(t0 + k) * PROJW + c0 + 8 * hh);
}
__device__ __forceinline__ void phase_conv(const Ctx& C, int l, int b0, int nb) {
    int tid_ = C.tid; asm volatile("" : "+v"(tid_)); const int lane_ = tid_ & 63;
    if (C.bid < b0 || C.bid >= b0 + nb) return;
    const int gw = (C.bid - b0) * 8 + C.wave, NGW = nb * 8;
    const bf16* proj = (const bf16*)(C.ws + WS_PROJ); bf16* mix = (bf16*)(C.ws + WS_MIX);
    const float* cw = C.conv_w + (size_t)l * 3 * 1024; const float* cg = C.conv_norm_g + (size_t)l * 1024;
    const int c0 = 16 * lane_;
    v4u a[4][2], b[4][2], cbv[2][2];
    if (gw < T / 2) conv_loads(proj, 2 * gw, c0, a, b, cbv);
    for (int tg = gw; tg < T / 2; tg += NGW) {
        const int t0 = 2 * tg;
        float y[2][16];
#pragma unroll
        for (int hh = 0; hh < 2; ++hh) {
            const f32x4 w0a = *(const f32x4*)(cw + c0 + 8 * hh), w0b = *(const f32x4*)(cw + c0 + 8 * hh + 4), w1a = *(const f32x4*)(cw + 1024 + c0 + 8 * hh), w1b = *(const f32x4*)(cw + 1024 + c0 + 8 * hh + 4);
            const f32x4 w2a = *(const f32x4*)(cw + 2048 + c0 + 8 * hh), w2b = *(const f32x4*)(cw + 2048 + c0 + 8 * hh + 4);
            float p[4][8];
#pragma unroll
            for (int r = 0; r < 4; ++r) { float fa[8], fb[8]; unpack8(a[r][hh], fa); unpack8(b[r][hh], fb);
#pragma unroll
                for (int i = 0; i < 8; ++i) p[r][i] = fa[i] * fb[i]; }
#pragma unroll
            for (int k = 0; k < 2; ++k) { float fc[8]; unpack8(cbv[k][hh], fc);
#pragma unroll
                for (int i = 0; i < 8; ++i) { const float w0 = i < 4 ? w0a[i & 3] : w0b[i & 3], w1 = i < 4 ? w1a[i & 3] : w1b[i & 3], w2 = i < 4 ? w2a[i & 3] : w2b[i & 3];
                    y[k][8 * hh + i] = fc[i] * (w0 * p[k][i] + w1 * p[k + 1][i] + w2 * p[k + 2][i]); } }
        }
        if (tg + NGW < T / 2) conv_loads(proj, 2 * (tg + NGW), c0, a, b, cbv);
        f32x4 g4[4];
#pragma unroll
        for (int q = 0; q < 4; ++q) g4[q] = *(const f32x4*)(cg + c0 + 4 * q);
#pragma unroll
        for (int k = 0; k < 2; ++k) {
            float ss = 0.f;
#pragma unroll
            for (int i = 0; i < 16; ++i) ss += y[k][i] * y[k][i];
            ss += __shfl_xor(ss, 1); ss += __shfl_xor(ss, 2); ss += __shfl_xor(ss, 4);
            const float rn = rsqrtf(ss * (1.0f / 128.0f) + EPS);
#pragma unroll
            for (int hh = 0; hh < 2; ++hh) { v4u o; float z[8];
#pragma unroll
                for (int i = 0; i < 8; ++i) z[i] = y[k][8 * hh + i] * rn * g4[2 * hh + (i >> 2)][i & 3];
                o.x = pkbf(z[0], z[1]); o.y = pkbf(z[2], z[3]); o.z = pkbf(z[4], z[5]); o.w = pkbf(z[6], z[7]);
                *(v4u*)(mix + (size_t)(t0 + k) * D + c0 + 8 * hh) = o; }
        }
    }
}

__device__ __forceinline__ void stage_tile(int tid, rsrc_t rsP, unsigned colbytes, LAS unsigned char* dst, const LAS float* rowscale, bool perm = false) {
    const int row0 = tid >> 5, c16 = tid & 31;
    const unsigned vo = (unsigned)(row0 * (PROJW * 2) + c16 * 16);
    LAS unsigned char* d0 = dst + row0 * TPITCH + (perm ? ((c16 >> 2) * 64 + (c16 & 3) * 8) : c16 * 16);
#pragma unroll
    for (int i = 0; i < 8; ++i) {
        v4u v = bld128(rsP, vo, colbytes + (unsigned)(i * 16 * PROJW * 2));
        if (rowscale) { float f[8]; unpack8(v, f); const float s = rowscale[row0 + 16 * i];
            v.x = pkbf(f[0] * s, f[1] * s); v.y = pkbf(f[2] * s, f[3] * s); v.z = pkbf(f[4] * s, f[5] * s); v.w = pkbf(f[6] * s, f[7] * s); }
        if (perm) { u32x2 lo, hi; lo.x = v.x; lo.y = v.y; hi.x = v.z; hi.y = v.w; *(LAS u32x2*)(d0 + i * 16 * TPITCH) = lo; *(LAS u32x2*)(d0 + i * 16 * TPITCH + 32) = hi; }
        else *(LAS v4u*)(d0 + i * 16 * TPITCH) = v;
        if (i == 3) __builtin_amdgcn_sched_barrier(0); }
}
__device__ __forceinline__ void bst128(v4u v, rsrc_t rs, unsigned voff, unsigned soff) { __builtin_amdgcn_raw_buffer_store_b128(v, rs, voff, soff, 0); }

__device__ __forceinline__ void tile_load(int tid, rsrc_t rsP, unsigned colbytes, v4u (&r)[8]) {
    const unsigned vo = (unsigned)((tid >> 5) * (PROJW * 2) + (tid & 31) * 16);
#pragma unroll
    for (int i = 0; i < 8; ++i) r[i] = bld128(rsP, vo, colbytes + (unsigned)(i * 16 * PROJW * 2));
}
__device__ __forceinline__ void tile_write(int tid, LAS unsigned char* dst, const v4u (&r)[8], const LAS float* rowscale, bool perm) {
    const int row0 = tid >> 5, c16 = tid & 31;
    LAS unsigned char* d0 = dst + row0 * TPITCH + (perm ? ((c16 >> 2) * 64 + (c16 & 3) * 8) : c16 * 16);
#pragma unroll
    for (int i = 0; i < 8; ++i) { v4u v = r[i];
        if (rowscale) { float f[8]; unpack8(v, f); const float sc = rowscale[row0 + 16 * i];
            v.x = pkbf(f[0] * sc, f[1] * sc); v.y = pkbf(f[2] * sc, f[3] * sc); v.z = pkbf(f[4] * sc, f[5] * sc); v.w = pkbf(f[6] * sc, f[7] * sc); }
        if (perm) { u32x2 lo, hi; lo.x = v.x; lo.y = v.y; hi.x = v.z; hi.y = v.w; *(LAS u32x2*)(d0 + i * 16 * TPITCH) = lo; *(LAS u32x2*)(d0 + i * 16 * TPITCH + 32) = hi; }
        else *(LAS v4u*)(d0 + i * 16 * TPITCH) = v; }
}
__device__ __forceinline__ void phase_m1(const Ctx& C) {
    const bf16* proj = (const bf16*)(C.ws + WS_PROJ); const float* gates = (const float*)(C.ws + WS_GATES);
    float* BQ = (float*)(C.ws + WS_BQ); float* BK = (float*)(C.ws + WS_BK); float* KMAX = (float*)(C.ws + WS_KMAX); float* BLAST = (float*)(C.ws + WS_BLAST); float* DN = (float*)(C.ws + WS_DN);
    bf16* S = (bf16*)(C.ws + WS_S);
    LAS unsigned char* VT = C.lds + VT_OFF; LAS unsigned char* KT = C.lds + KT_OFF; LAS float* SC = (LAS float*)(C.lds + SC_OFF);
    const int wave = C.wave;
    v4u vraw[8], kraw[8]; float ipn = 0.f, fpn = 0.f;
    if (C.bid < NCHUNK * 4) { int tid = C.tid; asm volatile("" : "+v"(tid)); const int cg = C.bid >> 2, h = C.bid & 3, t0 = cg * 128;
        const rsrc_t rsP = mkrsrc(proj + (size_t)t0 * PROJW, 128u * PROJW * 2u);
        tile_load(tid, rsP, (unsigned)((5120 + 256 * h) * 2), vraw); tile_load(tid, rsP, (unsigned)((4096 + 256 * h) * 2), kraw);
        if (tid < 256) { const float* gp = gates + (size_t)(t0 + (tid & 127)) * 16; const int dir = (tid >> 7) & 1; ipn = gp[8 * dir + h]; fpn = gp[8 * dir + 4 + h]; } }
    for (int un = C.bid; un < NCHUNK * 4; un += C.G) {
        int tid = C.tid; asm volatile("" : "+v"(tid));
        const int lane = tid & 63, fr = lane & 15, fq = lane >> 4, q4 = fr >> 2, p4 = fr & 3;
        const int cg = un >> 2, h = un & 3, t0 = cg * 128;
        const int dir = (tid >> 7) & 1, j = tid & 127;
        const float ip = ipn;
        __syncthreads();
        if (tid < 256) SC[tid] = fminf(fpn, 0.f) - log1pf(__expf(-fabsf(fpn)));
        tile_write(tid, VT, vraw, nullptr, false);
        __syncthreads();
        const float lfv = (tid < 256) ? SC[tid] : 0.f;
        float inc = lfv;
#pragma unroll
        for (int o = 1; o < 64; o <<= 1) { const float tpre = __shfl_up(inc, o); if (lane >= o) inc += tpre; }
        if (lane == 63 && wave < 4) SC[772 + wave] = inc;
        __syncthreads();
        float bqv = 0.f, bkv = -3.0e38f;
        if (tid < 256) { const float w0 = SC[772 + 2 * dir], w1 = SC[772 + 2 * dir + 1]; const float incl = inc + ((wave & 1) ? w0 : 0.f);
            bqv = dir == 0 ? incl : (w0 + w1) - incl + lfv; bkv = ip - bqv; }
        float mx = bkv;
#pragma unroll
        for (int o = 1; o < 64; o <<= 1) mx = fmaxf(mx, __shfl_xor(mx, o));
        if (lane == 0 && wave < 4) SC[768 + wave] = mx;
        __syncthreads();
        if (tid < 256) { const float kmax = fmaxf(SC[768 + 2 * dir], SC[768 + 2 * dir + 1]); SC[512 + tid] = __expf(bkv - kmax);
            BQ[(size_t)(dir * 4 + h) * T + t0 + j] = bqv; BK[(size_t)(dir * 4 + h) * T + t0 + j] = bkv;
            const int u = unit_of(dir, cg, h);
            if (j == 0) KMAX[u] = kmax;
            if ((dir == 0 && j == 127) || (dir == 1 && j == 0)) BLAST[u] = bqv; }
#pragma unroll
        for (int dd = 0; dd < 2; ++dd) {
            __syncthreads();
            tile_write(tid, KT, kraw, SC + 512 + dd * 128, true);
            __syncthreads();
            const int u = unit_of(dd, cg, h);
            if (tid < 256) { float s = 0.f; for (int r = 0; r < 128; ++r) s += bf2f(*(const LAS unsigned short*)(KT + r * TPITCH + 2 * tid));
                DN[(size_t)u * 256 + (tid & ~31) + 8 * ((tid >> 2) & 3) + 4 * ((tid >> 4) & 1) + (tid & 3)] = s; }
            if (dd == 1 && un + C.G < NCHUNK * 4) {
                const int un2 = un + C.G, cg2 = un2 >> 2, h2 = un2 & 3, t02 = cg2 * 128;
                const rsrc_t rsP2 = mkrsrc(proj + (size_t)t02 * PROJW, 128u * PROJW * 2u);
                tile_load(tid, rsP2, (unsigned)((5120 + 256 * h2) * 2), vraw); tile_load(tid, rsP2, (unsigned)((4096 + 256 * h2) * 2), kraw);
                if (tid < 256) { const float* gp = gates + (size_t)(t02 + j) * 16; ipn = gp[8 * dir + h2]; fpn = gp[8 * dir + 4 + h2]; } }
            const rsrc_t rsS = mkrsrc(S + (size_t)u * 65536, 131072u);
            const unsigned sv = (unsigned)(fr * 512 + 16 * fq);
#pragma unroll
            for (int hb = 0; hb < 2; ++hb) {
                f32x4 acc[2][8];
#pragma unroll
                for (int a = 0; a < 2; ++a)
#pragma unroll
                    for (int b = 0; b < 8; ++b) acc[a][b] = (f32x4){0.f, 0.f, 0.f, 0.f};
#pragma unroll 1
                for (int ks = 0; ks < 4; ++ks) {
                    const int rb = (32 * ks + 8 * fq + q4) * TPITCH + 8 * p4;
                    bf16x8 vf[2];
#pragma unroll
                    for (int a = 0; a < 2; ++a) { const int eo = (32 * wave + 16 * a) * 2; vf[a] = cat8(tr16(VT + rb + eo), tr16(VT + rb + 4 * TPITCH + eo)); }
#pragma unroll
                    for (int b = 0; b < 8; ++b) { const bf16x8 kf = cat8(tr16(KT + rb + 32 * (8 * hb + b)), tr16(KT + rb + 4 * TPITCH + 32 * (8 * hb + b)));
#pragma unroll
                        for (int a = 0; a < 2; ++a) acc[a][b] = __builtin_amdgcn_mfma_f32_16x16x32_bf16(kf, vf[a], acc[a][b], 0, 0, 0); }
                }
#pragma unroll
                for (int a = 0; a < 2; ++a)
#pragma unroll
                    for (int b2 = 0; b2 < 4; ++b2) { v4u w; w.x = pkbf(acc[a][2 * b2][0], acc[a][2 * b2][1]); w.y = pkbf(acc[a][2 * b2][2], acc[a][2 * b2][3]); w.z = pkbf(acc[a][2 * b2 + 1][0], acc[a][2 * b2 + 1][1]); w.w = pkbf(acc[a][2 * b2 + 1][2], acc[a][2 * b2 + 1][3]);
                        bst128(w, rsS, sv + 64u * (4 * hb + b2), (unsigned)((32 * wave + 16 * a) * 512)); }
            }
        }
    }
}

__device__ __forceinline__ void phase_m2_generic(const Ctx& C) {
    const float* KMAX = (const float*)(C.ws + WS_KMAX); const float* BLAST = (const float*)(C.ws + WS_BLAST); float* DN = (float*)(C.ws + WS_DN); float* US = (float*)(C.ws + WS_US);
    bf16* S = (bf16*)(C.ws + WS_S);
    LAS float* SC = (LAS float*)(C.lds + SC_OFF);
    int tid = C.tid; asm volatile("" : "+v"(tid));
    constexpr int N_PM = 128, N_SM = 512, N_V = 40, N_ALL = N_PM + N_SM + N_V;
    const int nmine = C.G == 256 ? (C.bid < 128 ? (C.bid < N_V ? 2 : 1) : 4) : (N_ALL - C.bid + C.G - 1) / C.G;
    for (int k = 0; k < nmine; ++k) {
        const int it = C.G == 256 ? (C.bid < 128 ? (k == 0 ? C.bid : N_PM + N_SM + C.bid) : N_PM + 4 * (C.bid - 128) + k) : C.bid + k * C.G;
        int dir, seq, h, slab;
        if (it < N_PM) { dir = it >> 6; h = (it >> 4) & 3; slab = it & 15; seq = 0; }
        else if (it < N_PM + N_SM) { const int r = it - N_PM; dir = r >> 8; seq = 1 + ((r >> 6) & 3); h = (r >> 4) & 3; slab = r & 15; }
        else { const int r = it - N_PM - N_SM; dir = r / 20; const int sh = r % 20; seq = sh >> 2; h = sh & 3; slab = 16; }
        const int c0 = seq == 0 ? 0 : 128 + 16 * (seq - 1), nc = seq == 0 ? 128 : 16;
        __syncthreads();
        if (tid < nc) { const int cg = dir == 0 ? c0 + tid : c0 + nc - 1 - tid; const int u = unit_of(dir, cg, h); SC[tid] = KMAX[u]; SC[128 + tid] = BLAST[u]; }
        __syncthreads();
        if (tid == 0) { float m = 0.f;
            for (int c = 0; c < nc; c += 8) { float kx[8], bl[8];
#pragma unroll
                for (int i = 0; i < 8; ++i) { kx[i] = SC[c + i]; bl[i] = SC[128 + c + i]; }
#pragma unroll
                for (int i = 0; i < 8; ++i) { SC[256 + c + i] = m; m = bl[i] + fmaxf(m, kx[i]); } } }
        __syncthreads();
        if (tid < nc) { const float m = SC[256 + tid], kx = SC[tid], M = fmaxf(m, kx); SC[384 + tid] = __expf(m - M); SC[512 + tid] = __expf(kx - M);
            if (slab == 16) { const int cg = dir == 0 ? c0 + tid : c0 + nc - 1 - tid; float* us = US + (size_t)unit_of(dir, cg, h) * 4; us[0] = __expf(m - M); us[1] = __expf(kx - M); us[2] = M; us[3] = 0.f; } }
        __syncthreads();
        if (slab < 16) {
            float c8[8];
#pragma unroll
            for (int j = 0; j < 8; ++j) c8[j] = 0.f;
            const size_t eoff = (size_t)slab * 4096 + tid * 8;
            const int ustep = dir == 0 ? 4 : -4;
            bf16* p = S + (size_t)unit_of(dir, dir == 0 ? c0 : c0 + nc - 1, h) * 65536 + eoff;
            v4u d[16];
#pragma unroll
            for (int i = 0; i < 16; ++i) d[i] = __builtin_nontemporal_load((const v4u*)(p + (ptrdiff_t)(i * ustep) * 65536));
            for (int cb = 0; cb < nc; cb += 16) {
                v4u dn[16];
                const bool more = cb + 16 < nc;
                if (more) {
#pragma unroll
                    for (int i = 0; i < 16; ++i) dn[i] = __builtin_nontemporal_load((const v4u*)(p + (ptrdiff_t)((16 + i) * ustep) * 65536));
                }
#pragma unroll
                for (int i = 0; i < 16; ++i) { const float a = SC[384 + cb + i], b = SC[512 + cb + i];
                    v4u w; w.x = pkbf(c8[0], c8[1]); w.y = pkbf(c8[2], c8[3]); w.z = pkbf(c8[4], c8[5]); w.w = pkbf(c8[6], c8[7]);
                    *(v4u*)(p + (ptrdiff_t)(i * ustep) * 65536) = w;
                    float f[8]; unpack8(d[i], f);
#pragma unroll
                    for (int j = 0; j < 8; ++j) c8[j] = a * c8[j] + b * f[j]; }
                if (more) {
#pragma unroll
                    for (int i = 0; i < 16; ++i) d[i] = dn[i];
                }
                p += (ptrdiff_t)(16 * ustep) * 65536;
            }
        } else if (tid < 256) {
            float nv = 0.f;
            for (int c = 0; c < nc; ++c) { const int cg = dir == 0 ? c0 + c : c0 + nc - 1 - c; float* p = DN + (size_t)unit_of(dir, cg, h) * 256 + tid; const float dv = *p; *p = nv; nv = SC[384 + c] * nv + SC[512 + c] * dv; }
        }
    }
}

__device__ __forceinline__ void m2_decode_matrix(int it, bool prompt, int& dir, int& seq, int& h, int& slab) {
    if (prompt) { dir = it >> 7; h = (it >> 5) & 3; slab = it & 31; seq = 0; }
    else { dir = it >> 9; seq = 1 + ((it >> 7) & 3); h = (it >> 5) & 3; slab = it & 31; }
}
__device__ __forceinline__ void m2_stream(bf16* S, const LAS float* tab, int dir, int seq, int h, int slab, int t256) {
    const int c0 = seq == 0 ? 0 : 128 + 16 * (seq - 1), nc = seq == 0 ? 128 : 16;
    float c8[8];
#pragma unroll
    for (int j = 0; j < 8; ++j) c8[j] = 0.f;
    const int ustep = dir == 0 ? 4 : -4;
    bf16* p = S + (size_t)unit_of(dir, dir == 0 ? c0 : c0 + nc - 1, h) * 65536 + (size_t)slab * 2048 + t256 * 8;
    v4u d[16];
#pragma unroll
    for (int i = 0; i < 16; ++i) d[i] = __builtin_nontemporal_load((const v4u*)(p + (ptrdiff_t)(i * ustep) * 65536));
    for (int cb = 0; cb < nc; cb += 16) {
        v4u dn[16]; const bool more = cb + 16 < nc;
        if (more) {
#pragma unroll
            for (int i = 0; i < 16; ++i) dn[i] = __builtin_nontemporal_load((const v4u*)(p + (ptrdiff_t)((16 + i) * ustep) * 65536));
        }
#pragma unroll
        for (int i = 0; i < 16; ++i) { const float a = tab[384 + cb + i], b = tab[512 + cb + i];
            v4u w; w.x = pkbf(c8[0], c8[1]); w.y = pkbf(c8[2], c8[3]); w.z = pkbf(c8[4], c8[5]); w.w = pkbf(c8[6], c8[7]);
            *(v4u*)(p + (ptrdiff_t)(i * ustep) * 65536) = w;
            float f[8]; unpack8(d[i], f);
#pragma unroll
            for (int j = 0; j < 8; ++j) c8[j] = a * c8[j] + b * f[j]; }
        if (more) {
#pragma unroll
            for (int i = 0; i < 16; ++i) d[i] = dn[i];
        }
        p += (ptrdiff_t)(16 * ustep) * 65536;
    }
}
__device__ __forceinline__ void phase_m2(const Ctx& C) {
    if (C.G != 256) { phase_m2_generic(C); return; }
    const float* KMAX = (const float*)(C.ws + WS_KMAX); const float* BLAST = (const float*)(C.ws + WS_BLAST); float* DN = (float*)(C.ws + WS_DN); float* US = (float*)(C.ws + WS_US);
    bf16* S = (bf16*)(C.ws + WS_S);
    LAS float* SC = (LAS float*)(C.lds + SC_OFF);
    int tid = C.tid; asm volatile("" : "+v"(tid));
    const bool has_vec = C.bid < 40;
    __syncthreads();
#pragma unroll 1
    for (int t = 0; t < 6; ++t) {
        int dir, seq, h, slab;
        if (t == 0) m2_decode_matrix(C.bid, true, dir, seq, h, slab); else if (t < 5) m2_decode_matrix(4 * C.bid + t - 1, false, dir, seq, h, slab);
        else { if (!has_vec) break; dir = C.bid / 20; const int sh = C.bid % 20; seq = sh >> 2; h = sh & 3; }
        const int c0 = seq == 0 ? 0 : 128 + 16 * (seq - 1), nc = seq == 0 ? 128 : 16;
        if (tid < nc) { const int cg = dir == 0 ? c0 + tid : c0 + nc - 1 - tid; const int u = unit_of(dir, cg, h); SC[t * 640 + tid] = KMAX[u]; SC[t * 640 + 128 + tid] = BLAST[u]; }
    }
    __syncthreads();
    if (tid < 6 && (tid < 5 || has_vec)) { LAS float* tb = SC + tid * 640; const int nc = (tid == 0 || (tid == 5 && (C.bid % 20) < 4)) ? 128 : 16; float m = 0.f;
        for (int c = 0; c < nc; c += 8) { float kx[8], bl[8];
#pragma unroll
            for (int i = 0; i < 8; ++i) { kx[i] = tb[c + i]; bl[i] = tb[128 + c + i]; }
#pragma unroll
            for (int i = 0; i < 8; ++i) { tb[256 + c + i] = m; m = bl[i] + fmaxf(m, kx[i]); } } }
    __syncthreads();
#pragma unroll 1
    for (int t = 0; t < 6; ++t) {
        if (t == 5 && !has_vec) break;
        const int nc = (t == 0 || (t == 5 && (C.bid % 20) < 4)) ? 128 : 16;
        if (tid < nc) { LAS float* tb = SC + t * 640; const float m = tb[256 + tid], kx = tb[tid], M = fmaxf(m, kx); tb[384 + tid] = __expf(m - M); tb[512 + tid] = __expf(kx - M);
            if (t == 5) { const int dir = C.bid / 20, sh = C.bid % 20, seq = sh >> 2, h = sh & 3; const int c0 = seq == 0 ? 0 : 128 + 16 * (seq - 1);
                const int cg = dir == 0 ? c0 + tid : c0 + nc - 1 - tid; float* us = US + (size_t)unit_of(dir, cg, h) * 4; us[0] = __expf(m - M); us[1] = __expf(kx - M); us[2] = M; us[3] = 0.f; } }
    }
    __syncthreads();
    if (tid < 256) { int dir, seq, h, slab; m2_decode_matrix(C.bid, true, dir, seq, h, slab); m2_stream(S, SC, dir, seq, h, slab, tid); }
    else {
        const int t2 = tid - 256;
#pragma unroll 1
        for (int k = 0; k < 4; ++k) { int dir, seq, h, slab; m2_decode_matrix(4 * C.bid + k, false, dir, seq, h, slab); m2_stream(S, SC + (1 + k) * 640, dir, seq, h, slab, t2); }
        if (has_vec) { const int dir = C.bid / 20, sh = C.bid % 20, seq = sh >> 2, h = sh & 3; const int c0 = seq == 0 ? 0 : 128 + 16 * (seq - 1), nc = seq == 0 ? 128 : 16;
            const LAS float* tb = SC + 5 * 640; float nv = 0.f;
            for (int c = 0; c < nc; ++c) { const int cg = dir == 0 ? c0 + c : c0 + nc - 1 - c; float* p = DN + (size_t)unit_of(dir, cg, h) * 256 + t2; const float dv = *p; *p = nv; nv = tb[384 + c] * nv + tb[512 + c] * dv; } }
    }
}

__device__ __forceinline__ void m3_fetch(const Ctx& C, int l, int tid, int wave, int un, v4u (&vraw)[8], v4u (&kraw)[8], float (&scn)[3]) {
    const bf16* proj = (const bf16*)(C.ws + WS_PROJ); const float* BK = (const float*)(C.ws + WS_BK); const float* KMAX = (const float*)(C.ws + WS_KMAX); const float* DN = (const float*)(C.ws + WS_DN);
    const int cg = un >> 2, h = un & 3, t0 = cg * 128; (void)wave;
    const rsrc_t rsP = mkrsrc(proj + (size_t)t0 * PROJW, 128u * PROJW * 2u);
    tile_load(tid, rsP, (unsigned)((5120 + 256 * h) * 2), vraw); tile_load(tid, rsP, (unsigned)((4096 + 256 * h) * 2), kraw);
    const int dd = tid >> 8, ix = tid & 255, ud = unit_of(dd, cg, h);
    scn[0] = DN[(size_t)ud * 256 + ix];
    scn[1] = ix < 128 ? __expf(BK[(size_t)(dd * 4 + h) * T + t0 + ix] - KMAX[ud]) : 0.f;
    scn[2] = dd == 0 ? C.mlstm_norm_g[(size_t)l * 1024 + 256 * h + ix] : 0.f;
}
__device__ __forceinline__ void phase_m3(const Ctx& C, int l, unsigned long long* tm = nullptr) {
    const bf16* proj = (const bf16*)(C.ws + WS_PROJ); bf16* mix = (bf16*)(C.ws + WS_MIX);
    const float* BQ = (const float*)(C.ws + WS_BQ);
    const float* US = (const float*)(C.ws + WS_US); const bf16* S = (const bf16*)(C.ws + WS_S);
    LAS unsigned char* VT = C.lds + VT_OFF; LAS unsigned char* KT = C.lds + KT_OFF; LAS float* SC = (LAS float*)(C.lds + SC_OFF);
    const int wave = C.wave;
    v4u vraw[8], kraw[8]; float scn[3] = {0.f, 0.f, 0.f};
    if (C.bid < NCHUNK * 4) { int tid = C.tid; asm volatile("" : "+v"(tid)); m3_fetch(C, l, tid, wave, C.bid, vraw, kraw, scn); }
    for (int un = C.bid; un < NCHUNK * 4; un += C.G) {
        int tid = C.tid; asm volatile("" : "+v"(tid));
        const int lane = tid & 63, fr = lane & 15, fq = lane >> 4, q4 = fr >> 2, p4 = fr & 3;
        const int cg = un >> 2, h = un & 3, t0 = cg * 128, tl = 16 * wave + fr, t = t0 + tl;
        const rsrc_t rsP = mkrsrc(proj + (size_t)t0 * PROJW, 128u * PROJW * 2u);
        const unsigned pv = (unsigned)(tl * (PROJW * 2));
        unsigned long long tq0 = 0ull; if (tm) tq0 = __builtin_amdgcn_s_memrealtime();
        __syncthreads();
        bf16x8 qf[8];
#pragma unroll
        for (int ks = 0; ks < 8; ++ks) qf[ks] = __builtin_bit_cast(bf16x8, bld128(rsP, pv + 16u * fq + 64u * ks, (unsigned)((3072 + 256 * h) * 2)));
        { const int dd = tid >> 8, ix = tid & 255;
          SC[256 * dd + ix] = scn[0];
          if (ix < 128) SC[512 + 128 * dd + ix] = scn[1];
          if (dd == 0) SC[768 + ix] = scn[2]; }
        tile_write(tid, VT, vraw, nullptr, true);
        tile_write(tid, KT, kraw, nullptr, false);
        bf16x8 pf[2][4]; float al[2], inv[2];
        __syncthreads();
        if (tm) { const unsigned long long t_ = __builtin_amdgcn_s_memrealtime(); tm[0] += t_ - tq0; tq0 = t_; }
#pragma unroll
        for (int dir = 0; dir < 2; ++dir) {
            const int u = unit_of(dir, cg, h);
            const float be = US[(size_t)u * 4 + 1], MM = US[(size_t)u * 4 + 2], bqt = BQ[(size_t)(dir * 4 + h) * T + t];
            al[dir] = US[(size_t)u * 4];
            const LAS float* nv = SC + 256 * dir; const LAS float* wkv = SC + 512 + 128 * dir;
            float qn = 0.f;
#pragma unroll
            for (int ks = 0; ks < 8; ++ks) {
                const f32x4 n0 = *(const LAS f32x4*)(nv + 32 * ks + 8 * fq), n1 = *(const LAS f32x4*)(nv + 32 * ks + 8 * fq + 4);
#pragma unroll
                for (int j = 0; j < 4; ++j) qn += bf2f((unsigned short)qf[ks][j]) * n0[j] + bf2f((unsigned short)qf[ks][4 + j]) * n1[j];
                __builtin_amdgcn_sched_barrier(0);
            }
            qn += __shfl_xor(qn, 16); qn += __shfl_xor(qn, 32);
            float rsum = 0.f;
            const int sp_lo = dir == 0 ? 0 : (wave >> 1), sp_hi = dir == 0 ? (wave >> 1) : 3;
#pragma unroll
            for (int sp = 0; sp < 4; ++sp) {
                v4u pw; pw.x = 0u; pw.y = 0u; pw.z = 0u; pw.w = 0u;
                if (sp >= sp_lo && sp <= sp_hi) {
                    f32x4 st0 = (f32x4){0.f, 0.f, 0.f, 0.f}, st1 = (f32x4){0.f, 0.f, 0.f, 0.f};
                    LAS const unsigned char* kb = KT + (32 * sp + fr) * TPITCH + 16 * fq;
#pragma unroll
                    for (int ks = 0; ks < 8; ++ks) { const bf16x8 k0 = *(LAS const bf16x8*)(kb + 64 * ks), k1 = *(LAS const bf16x8*)(kb + 16 * TPITCH + 64 * ks);
                        st0 = __builtin_amdgcn_mfma_f32_16x16x32_bf16(k0, qf[ks], st0, 0, 0, 0); st1 = __builtin_amdgcn_mfma_f32_16x16x32_bf16(k1, qf[ks], st1, 0, 0, 0);
                        if ((ks & 3) == 3) __builtin_amdgcn_sched_barrier(0); }
                    const f32x4 wk0 = *(const LAS f32x4*)(wkv + 32 * sp + 4 * fq) * be, wk1 = *(const LAS f32x4*)(wkv + 32 * sp + 16 + 4 * fq) * be;
                    int tlx = tl - 4 * fq; asm volatile("" : "+v"(tlx));
#pragma unroll
                    for (int jj = 0; jj < 4; ++jj) { const int s0 = 32 * sp + jj, s1 = s0 + 16;
                        const bool k0 = dir == 0 ? (s0 <= tlx) : (s0 >= tlx), k1 = dir == 0 ? (s1 <= tlx) : (s1 >= tlx);
                        st0[jj] = k0 ? st0[jj] * wk0[jj] : 0.f; st1[jj] = k1 ? st1[jj] * wk1[jj] : 0.f; rsum += st0[jj] + st1[jj]; }
                    pw.x = pkbf(st0[0], st0[1]); pw.y = pkbf(st0[2], st0[3]); pw.z = pkbf(st1[0], st1[1]); pw.w = pkbf(st1[2], st1[3]);
                }
                pf[dir][sp] = __builtin_bit_cast(bf16x8, pw);
            }
            rsum += __shfl_xor(rsum, 16); rsum += __shfl_xor(rsum, 32);
            const float den = al[dir] * qn + rsum, lower = __expf(-bqt - MM);
            inv[dir] = __builtin_amdgcn_rcpf(fmaxf(fabsf(den), lower));
        }
        __syncthreads();
        if (tm) { const unsigned long long t_ = __builtin_amdgcn_s_memrealtime(); tm[1] += t_ - tq0; tq0 = t_; }
        f32x4 hs[16];
        const int dl = lane & 31, dh = lane >> 5;
#define M3_ISSUE(sl) do { const bf16* src_ = S + (size_t)unit_of((sl) & 1, cg, h) * 65536 + (size_t)(64 * ((sl) >> 1)) * 256; \
            _Pragma("unroll") for (int i_ = 0; i_ < 4; ++i_) { const int row_ = 2 * (4 * wave + i_) + dh; \
                const int erow_ = 32 * (row_ >> 5) + 8 * ((row_ & 15) >> 2) + 4 * ((row_ >> 4) & 1) + (row_ & 3);     \
                __builtin_amdgcn_global_load_lds((const unsigned*)(src_ + (size_t)erow_ * 256 + ((dl ^ (row_ & 15)) * 8)), (LAS unsigned*)(KT + ((sl) & 1) * 32768 + (4 * wave + i_) * 1024), 16, 0, 0); } } while (0)
        M3_ISSUE(0);
#pragma unroll
        for (int sl = 0; sl < 8; ++sl) {
            const int qt = sl >> 1, dir = sl & 1;
            asm volatile("s_waitcnt vmcnt(0)" ::: "memory"); __builtin_amdgcn_s_barrier(); asm volatile("" ::: "memory");
            if (sl + 1 < 8) M3_ISSUE(sl + 1);
            const int sp_lo = dir == 0 ? 0 : (wave >> 1), sp_hi = dir == 0 ? (wave >> 1) : 3;
            LAS const unsigned char* cb = KT + (sl & 1) * 32768 + fr * 512;
            f32x4 acc[4];
#pragma unroll
            for (int e4 = 0; e4 < 4; ++e4) acc[e4] = (f32x4){0.f, 0.f, 0.f, 0.f};
#pragma unroll
            for (int ks = 0; ks < 8; ++ks) {
                const int ch = ((4 * ks + fq) ^ fr) * 16;
#pragma unroll
                for (int e4 = 0; e4 < 4; ++e4) { const bf16x8 cf = *(LAS const bf16x8*)(cb + e4 * 8192 + ch); acc[e4] = __builtin_amdgcn_mfma_f32_16x16x32_bf16(cf, qf[ks], acc[e4], 0, 0, 0); }
            }
#pragma unroll
            for (int e4 = 0; e4 < 4; ++e4) acc[e4] = acc[e4] * al[dir];
#pragma unroll
            for (int sp = 0; sp < 4; ++sp) {
                if (sp >= sp_lo && sp <= sp_hi) {
                    LAS const unsigned char* vb = VT + (32 * sp + 4 * fq + q4) * TPITCH + 8 * p4 + 32 * 4 * qt;
#pragma unroll
                    for (int e4 = 0; e4 < 4; ++e4) { const bf16x8 vf = cat8(tr16(vb + 32 * e4), tr16(vb + 16 * TPITCH + 32 * e4)); acc[e4] = __builtin_amdgcn_mfma_f32_16x16x32_bf16(vf, pf[dir][sp], acc[e4], 0, 0, 0); }
                }
            }
#pragma unroll
            for (int e4 = 0; e4 < 4; ++e4) { if (dir == 0) hs[4 * qt + e4] = acc[e4] * inv[0]; else hs[4 * qt + e4] += acc[e4] * inv[1]; }
        }
#undef M3_ISSUE
        if (tm) { const unsigned long long t_ = __builtin_amdgcn_s_memrealtime(); tm[2] += t_ - tq0; tq0 = t_; }
        v4u owv[8];
#pragma unroll
        for (int i = 0; i < 8; ++i) owv[i] = bld128(rsP, pv + 16u * fq + 64u * i, (unsigned)((6144 + 256 * h) * 2));
        float ss = 0.f;
#pragma unroll
        for (int eb = 0; eb < 16; ++eb) ss += (hs[eb][0] * hs[eb][0] + hs[eb][1] * hs[eb][1]) + (hs[eb][2] * hs[eb][2] + hs[eb][3] * hs[eb][3]);
        ss += __shfl_xor(ss, 16); ss += __shfl_xor(ss, 32);
        const float rn = rsqrtf(ss * (1.0f / 256.0f) + EPS);
        v4u yk[8];
#pragma unroll
        for (int i = 0; i < 8; ++i) { const f32x4 ga = *(const LAS f32x4*)(SC + 768 + 32 * i + 8 * fq), gb = *(const LAS f32x4*)(SC + 768 + 32 * i + 8 * fq + 4);
            float o[8]; unpack8(owv[i], o); float y[8];
#pragma unroll
            for (int j = 0; j < 4; ++j) { y[j] = hs[2 * i][j] * rn * ga[j] * __builtin_amdgcn_rcpf(1.0f + __expf(-o[j])); y[4 + j] = hs[2 * i + 1][j] * rn * gb[j] * __builtin_amdgcn_rcpf(1.0f + __expf(-o[4 + j])); }
            yk[i].x = pkbf(y[0], y[1]); yk[i].y = pkbf(y[2], y[3]); yk[i].z = pkbf(y[4], y[5]); yk[i].w = pkbf(y[6], y[7]); }
        asm volatile("" ::: "memory");
        { int tf = C.tid; asm volatile("" : "+v"(tf));
          m3_fetch(C, l, tf, wave, (un + C.G < NCHUNK * 4) ? un + C.G : un, vraw, kraw, scn); }
        const rsrc_t rsM = mkrsrc(mix + (size_t)t0 * D, 128u * D * 2u);
#pragma unroll
        for (int i = 0; i < 8; ++i) bst128(yk[i], rsM, (unsigned)(tl * (D * 2)) + 16u * fq + 64u * i, (unsigned)((1024 + 256 * h) * 2));
        if (tm) { const unsigned long long t_ = __builtin_amdgcn_s_memrealtime(); tm[3] += t_ - tq0; }
    }
}

__device__ __forceinline__ void glufix_row(const Ctx& C, int l, int tid_, int row, const float* hm, const float* h0, const float* hp) {
    const float* fw = C.ffn_conv_w + (size_t)l * 3 * NUP; const float* fb = C.ffn_conv_b + (size_t)l * NUP; bf16* act = (bf16*)(C.ws + WS_ACT);
    for (int f = 4 * tid_; f < DFF; f += 4 * 512) {
        const f32x4 w0g = *(const f32x4*)(fw + f), w1g = *(const f32x4*)(fw + NUP + f), w2g = *(const f32x4*)(fw + 2 * NUP + f), bg = *(const f32x4*)(fb + f);
        const f32x4 w0v = *(const f32x4*)(fw + DFF + f), w1v = *(const f32x4*)(fw + NUP + DFF + f), w2v = *(const f32x4*)(fw + 2 * NUP + DFF + f), bv = *(const f32x4*)(fb + DFF + f);
        const f32x4 ag = *(const f32x4*)(hm + f), av = *(const f32x4*)(hm + DFF + f), bgv = *(const f32x4*)(h0 + f), bvv = *(const f32x4*)(h0 + DFF + f), cg4 = *(const f32x4*)(hp + f), cv4 = *(const f32x4*)(hp + DFF + f);
        float z[4];
#pragma unroll
        for (int j = 0; j < 4; ++j) { const float g = bg[j] + w0g[j] * ag[j] + w1g[j] * bgv[j] + w2g[j] * cg4[j], vv = bv[j] + w0v[j] * av[j] + w1v[j] * bvv[j] + w2v[j] * cv4[j];
            z[j] = g * __builtin_amdgcn_rcpf(1.0f + __expf(-g)) * vv; }
        u32x2 w; w.x = pkbf(z[0], z[1]); w.y = pkbf(z[2], z[3]);
        *(u32x2*)(act + (size_t)row * DFF + f) = w;
    }
}
__device__ __forceinline__ bool seq_start_panel(int pm) { return pm == 0 || pm == 64 || (pm > 64 && ((pm - 64) & 7) == 0); }
__device__ __forceinline__ void glufix_panel(const Ctx& C, int l, int tid_, int pm) {
    const float* HB = (const float*)(C.ws + WS_HB);
    if (!seq_start_panel(pm)) glufix_row(C, l, tid_, 256 * pm, HB + (size_t)((pm - 1) * 4 + 3) * NUP, HB + (size_t)(pm * 4 + 0) * NUP, HB + (size_t)(pm * 4 + 1) * NUP);
    if (pm + 1 < 96 && !seq_start_panel(pm + 1)) glufix_row(C, l, tid_, 256 * pm + 255, HB + (size_t)(pm * 4 + 2) * NUP, HB + (size_t)(pm * 4 + 3) * NUP, HB + (size_t)((pm + 1) * 4 + 0) * NUP);
}

__device__ __forceinline__ void phase_final(const Ctx& C) {
    int tid_ = C.tid; asm volatile("" : "+v"(tid_)); const int lane_ = tid_ & 63;
    const int gw = C.bid * 8 + C.wave, NGW = C.G * 8;
    const bf16* xl = (const bf16*)(C.ws + WS_X); const bf16* xh = (const bf16*)(C.ws + WS_XB);
    const f32x4* g4 = (const f32x4*)C.final_norm_g + lane_;
    u32x2 a[8], b[8];
    if (gw < T) { const u32x2* h2 = (const u32x2*)(xh + (size_t)gw * D) + lane_; const u32x2* l2 = (const u32x2*)(xl + (size_t)gw * D) + lane_;
#pragma unroll
        for (int j = 0; j < 8; ++j) { a[j] = h2[64 * j]; if (MK_RESID_LO) b[j] = l2[64 * j]; else { b[j].x = 0u; b[j].y = 0u; } } }
    for (int r = gw; r < T; r += NGW) {
        u32x2 an[8], bn[8]; const int rn = r + NGW;
        if (rn < T) { const u32x2* h2 = (const u32x2*)(xh + (size_t)rn * D) + lane_; const u32x2* l2 = (const u32x2*)(xl + (size_t)rn * D) + lane_;
#pragma unroll
            for (int j = 0; j < 8; ++j) { an[j] = h2[64 * j]; if (MK_RESID_LO) bn[j] = l2[64 * j]; else { bn[j].x = 0u; bn[j].y = 0u; } } }
        f32x4* d4 = (f32x4*)(C.out + (size_t)r * D) + lane_;
        f32x4 v[8]; float ss = 0.f;
#pragma unroll
        for (int j = 0; j < 8; ++j) {
            v[j][0] = __uint_as_float(a[j].x << 16) + __uint_as_float(b[j].x << 16); v[j][1] = __uint_as_float(a[j].x & 0xffff0000u) + __uint_as_float(b[j].x & 0xffff0000u);
            v[j][2] = __uint_as_float(a[j].y << 16) + __uint_as_float(b[j].y << 16); v[j][3] = __uint_as_float(a[j].y & 0xffff0000u) + __uint_as_float(b[j].y & 0xffff0000u);
            ss += (v[j][0] * v[j][0] + v[j][1] * v[j][1]) + (v[j][2] * v[j][2] + v[j][3] * v[j][3]); }
        const float rs = rsqrtf(wave_sum(ss) * (1.0f / 2048.0f) + EPS);
#pragma unroll
        for (int j = 0; j < 8; ++j) d4[64 * j] = v[j] * rs * g4[64 * j];
        if (rn < T) {
#pragma unroll
            for (int j = 0; j < 8; ++j) { a[j] = an[j]; b[j] = bn[j]; } }
    }
}

template <class Sched> __device__ __forceinline__ pg8::RsTab rs_table_fill(const Ctx& C, const Sched& S, const float* ps) {
    pg8::RsTab rt; rt.tab = (LAS const float*)(C.lds + RST_OFF); rt.pm0 = rt.pm1 = rt.pm2 = rt.pm3 = -1; rt.ps = ps;
    pg8::Unit uu;
    for (int i = 0; S.next(i, uu); ++i) { const int p = uu.pm;
        if (p == rt.pm0 || p == rt.pm1 || p == rt.pm2 || p == rt.pm3) continue;
        if (rt.pm0 < 0) rt.pm0 = p; else if (rt.pm1 < 0) rt.pm1 = p; else if (rt.pm2 < 0) rt.pm2 = p; else if (rt.pm3 < 0) rt.pm3 = p; }
    int tid_ = C.tid; asm volatile("" : "+v"(tid_));
    LAS float* tab = (LAS float*)(C.lds + RST_OFF);
    if (tid_ < 256) {
        if (rt.pm0 >= 0) tab[tid_] = pg8::rstd_of_row(ps + (size_t)(rt.pm0 * 256 + tid_) * 32);
        if (rt.pm1 >= 0) tab[256 + tid_] = pg8::rstd_of_row(ps + (size_t)(rt.pm1 * 256 + tid_) * 32);
        if (rt.pm2 >= 0) tab[512 + tid_] = pg8::rstd_of_row(ps + (size_t)(rt.pm2 * 256 + tid_) * 32);
        if (rt.pm3 >= 0) tab[768 + tid_] = pg8::rstd_of_row(ps + (size_t)(rt.pm3 * 256 + tid_) * 32);
    }
    __syncthreads();
    return rt;
}

#ifndef MK_STAG
#define MK_STAG 0
#endif
__device__ __forceinline__ void stagger(const Ctx& C, unsigned ticks) {
    if (!MK_STAG) return;
    const unsigned g = (unsigned)C.bid & 3u;
    if (g) { const unsigned long long t0 = __builtin_amdgcn_s_memrealtime(); while (__builtin_amdgcn_s_memrealtime() - t0 < (unsigned long long)(g * ticks)) __builtin_amdgcn_s_sleep(4); }
}

constexpr int N_PHASES = 30;
#ifndef MK_REP_X0
#define MK_REP_X0 0
#endif
#ifndef MK_REP_FIN
#define MK_REP_FIN 0
#endif
#ifndef MK_TIME_PHASE
#define MK_TIME_PHASE -1
#endif
#ifndef MK_REP_V1
#define MK_REP_V1 0
#endif
#ifndef MK_REP_V4
#define MK_REP_V4 0
#endif
#ifndef MK_XBAR
#define MK_XBAR 0
#endif
#ifndef MK_ONE_LAUNCH
#define MK_ONE_LAUNCH 1
#endif
struct Args { const float* in[15]; float* out; unsigned char* ws; int ph_lo, ph_hi, use_bar, pad; };
__global__ void __launch_bounds__(512, 2) mk_fwd(Args args) {
    extern __shared__ __attribute__((aligned(16))) unsigned char lds[];
    Ctx C;
    C.lds = (LAS unsigned char*)lds; C.tid = threadIdx.x; C.lane = C.tid & 63; C.wave = __builtin_amdgcn_readfirstlane(C.tid >> 6); C.G = gridDim.x; C.bid = blockIdx.x;
    C.x_prompt = args.in[0]; C.x_sample = args.in[1]; C.norm_mix_g = args.in[2]; C.w_in = args.in[3]; C.gate_b = args.in[4]; C.conv_w = args.in[5]; C.conv_norm_g = args.in[6]; C.mlstm_norm_g = args.in[7];
    C.w_out = args.in[8]; C.norm_ffn_g = args.in[9]; C.w_up = args.in[10]; C.ffn_conv_w = args.in[11]; C.ffn_conv_b = args.in[12]; C.w_down = args.in[13]; C.final_norm_g = args.in[14];
    C.out = args.out; C.ws = args.ws;
    volatile LAS unsigned* MISC = (volatile LAS unsigned*)(C.lds + MISC_OFF);
    if (C.tid < 64) MISC[C.tid] = 0u;
    __syncthreads();
    unsigned* barw = (unsigned*)(C.ws + WS_CTL) + CW_BAR;
    XcdBarrier bar; bar.bar = barw; bar.x = 0; bar.st = nullptr;
    if (args.use_bar) bar = xcd_barrier_post(barw, MISC + 8);
    const int lo = args.ph_lo, hi = args.ph_hi;
#define IN(k) (lo <= (k) && (k) < hi)
    unsigned long long tacc = 0ull, tph0 = 0ull; unsigned long long tm3[4] = {0ull, 0ull, 0ull, 0ull}; unsigned long long tim1[3] = {0ull, 0ull, 0ull}, tim5[3] = {0ull, 0ull, 0ull}, tim4[3] = {0ull, 0ull, 0ull}, tim7[3] = {0ull, 0ull, 0ull};
#define TBEG(k) do { if (MK_TIME_PHASE == (k)) tph0 = __builtin_amdgcn_s_memrealtime(); } while (0)
#define TEND(k) do { if (MK_TIME_PHASE == (k)) tacc += __builtin_amdgcn_s_memrealtime() - tph0; } while (0)
#define SEAM(k) do { if (IN((k) + 1)) xcd_barrier(bar); } while (0)
    float* SS = (float*)(C.ws + WS_PS);
    bf16* XB = (bf16*)(C.ws + WS_XB);
    if (IN(0)) { for (int rep = 0; rep <= 4 * MK_REP_X0; ++rep) phase_x0(C); phase_w(C, 0); SEAM(0); }
#pragma unroll 1
    for (int l = 0; l < DEPTH; ++l) {
        const int pb = 1 + 7 * l;
        const unsigned char* W = C.ws + WS_W + (size_t)(l & 1) * W_BUF;
        if (IN(pb + 0)) { TBEG(0);
            pg8::Gemm g{XB, (const bf16*)(W + WO_IN), T, NINP, D}; pg8::StaticOrder S; S.init(T, NINP, C.G, C.bid);
            pg8::EpiProj E{(bf16*)(C.ws + WS_PROJ), (float*)(C.ws + WS_GATES), rs_table_fill(C, S, SS + (size_t)(2 * l) * T * 32), C.gate_b + l * 16};
            pg8::gemm_phase<pg8::EpiProj, pg8::StaticOrder, true, true>(C.lds, g, S, E, (MK_TIME_PHASE == 10 || MK_TIME_PHASE == 11) ? tim1 : nullptr);
            SEAM(pb + 0); TEND(0);
        }
        if (IN(pb + 1)) { TBEG(1); TBEG(40); phase_m1(C); __syncthreads(); TEND(40); TBEG(41); if (l + 1 < DEPTH) phase_w(C, l + 1, C.G == 256 ? 2 : 0); TEND(41); SEAM(pb + 1); TEND(1); }
        if (IN(pb + 2)) { TBEG(2); TBEG(30); TBEG(31); phase_m2(C); TEND(30); TEND(31); TBEG(32); phase_conv(C, l, 0, C.G); TEND(32); SEAM(pb + 2); TEND(2); }
        if (IN(pb + 3)) { TBEG(3); phase_m3(C, l, (MK_TIME_PHASE >= 50 && MK_TIME_PHASE <= 53) ? tm3 : nullptr); for (int xb_ = 0; xb_ < MK_XBAR; ++xb_) xcd_barrier(bar); SEAM(pb + 3); TEND(3); }
        if (IN(pb + 4)) { TBEG(4);
            pg8::Gemm g{(const bf16*)(C.ws + WS_MIX), (const bf16*)(W + WO_OUT), T, D, D}; pg8::StaticOrder S; S.init(T, D, C.G, C.bid);
            pg8::EpiResid E{XB, (bf16*)(C.ws + WS_X), SS + (size_t)(2 * l + 1) * T * 32, 1.f, 1, MK_RESID_LO != 0, MK_RESID_LO == 1};
            pg8::gemm_phase<pg8::EpiResid, pg8::StaticOrder, true, true>(C.lds, g, S, E, (MK_TIME_PHASE == 14 || MK_TIME_PHASE == 15) ? tim4 : nullptr);
            SEAM(pb + 4); TEND(4);
        }
        if (IN(pb + 5)) { TBEG(5);
            pg8::Gemm g{XB, (const bf16*)(W + WO_UP), T, NUP, D}; pg8::StaticOrder S; S.init(T, NUP, C.G, C.bid);
            pg8::EpiGlu E{(bf16*)(C.ws + WS_ACT), (float*)(C.ws + WS_HB), rs_table_fill(C, S, SS + (size_t)(2 * l + 1) * T * 32), C.ffn_conv_w + (size_t)l * 3 * NUP, C.ffn_conv_b + (size_t)l * NUP, C.lds + HALO_OFF};
            pg8::gemm_phase<pg8::EpiGlu, pg8::StaticOrder, true, true>(C.lds, g, S, E, (MK_TIME_PHASE == 12 || MK_TIME_PHASE == 13) ? tim5 : nullptr);
            if (l + 1 < DEPTH && C.G == 256) phase_w(C, l + 1, 1);
            SEAM(pb + 5); TEND(5);
        }
        if (IN(pb + 6)) { TBEG(6);
            pg8::Gemm g{(const bf16*)(C.ws + WS_ACT), (const bf16*)(W + WO_DOWN), T, D, DFF}; pg8::StaticOrder S; S.init(T, D, C.G, C.bid);
            { int tid_ = C.tid; asm volatile("" : "+v"(tid_)); pg8::Unit uu; int last_pm = -1;
              for (int i = 0; S.next(i, uu); ++i) { if (uu.pm != last_pm) glufix_panel(C, l, tid_, uu.pm); last_pm = uu.pm; }
              asm volatile("s_waitcnt vmcnt(0)" ::: "memory"); __syncthreads(); }
            pg8::EpiResid E{XB, (bf16*)(C.ws + WS_X), SS + (size_t)(2 * l + 2) * T * 32, 1.f, 1, MK_RESID_LO == 1, MK_RESID_LO != 0};
            pg8::gemm_phase<pg8::EpiResid, pg8::StaticOrder, true, true>(C.lds, g, S, E, (MK_TIME_PHASE == 16 || MK_TIME_PHASE == 17) ? tim7 : nullptr);
            SEAM(pb + 6); TEND(6);
        }
    }
    if (IN(29)) { for (int rep = 0; rep <= 4 * MK_REP_FIN; ++rep) phase_final(C); }
    if (MK_TIME_PHASE == 10) tacc = tim1[1]; if (MK_TIME_PHASE == 11) tacc = tim1[0]; if (MK_TIME_PHASE == 12) tacc = tim5[1]; if (MK_TIME_PHASE == 13) tacc = tim5[0]; if (MK_TIME_PHASE >= 50 && MK_TIME_PHASE <= 53) tacc = tm3[MK_TIME_PHASE - 50]; if (MK_TIME_PHASE == 14) tacc = tim4[1]; if (MK_TIME_PHASE == 15) tacc = tim4[0]; if (MK_TIME_PHASE == 16) tacc = tim7[1]; if (MK_TIME_PHASE == 17) tacc = tim7[0];
    if (MK_TIME_PHASE == 20) { const unsigned xcc = xb_xcc_id(); if (xcc != (blockIdx.x & 7u)) { const unsigned long long t0 = __builtin_amdgcn_s_memrealtime(); while (__builtin_amdgcn_s_memrealtime() - t0 < 100000ull) __builtin_amdgcn_s_sleep(8); } }
    if (MK_TIME_PHASE >= 0 && MK_TIME_PHASE != 20 && blockIdx.x == ((MK_TIME_PHASE == 31 || MK_TIME_PHASE == 32) ? 255u : 0u)) { const unsigned long long t0 = __builtin_amdgcn_s_memrealtime(); while (__builtin_amdgcn_s_memrealtime() - t0 < tacc) __builtin_amdgcn_s_sleep(8); }
#undef IN
#undef SEAM
}

extern "C" void kernel_launch(void* const* d_in, const int* in_sizes, int n_in, void* d_out, int out_size, void* d_ws, size_t ws_size, hipStream_t stream) {
    static int grid = 0;
    if (grid == 0) {
        if (n_in != 15 || out_size != T * D || ws_size < WS_END) { fprintf(stderr, "kernel_launch: unexpected shapes (n_in %d, out %d, ws %zu < %zu); nothing launched\n", n_in, out_size, ws_size, (size_t)WS_END); grid = -1; return; }
        int dev = 0, cus = 0, per_cu = 0;
        if (hipGetDevice(&dev) != hipSuccess || hipDeviceGetAttribute(&cus, hipDeviceAttributeMultiprocessorCount, dev) != hipSuccess) { grid = -1; return; }
        if (hipFuncSetAttribute((const void*)mk_fwd, hipFuncAttributeMaxDynamicSharedMemorySize, LDS_BYTES) != hipSuccess) { fprintf(stderr, "kernel_launch: hipFuncSetAttribute failed\n"); grid = -1; return; }
        if (hipOccupancyMaxActiveBlocksPerMultiprocessor(&per_cu, (const void*)mk_fwd, 512, LDS_BYTES) != hipSuccess || per_cu < 1) { fprintf(stderr, "kernel_launch: occupancy query says %d blocks per CU\n", per_cu); }
        (void)hipGetLastError();
        grid = cus;
    }
    if (grid < 0) return;
    (void)hipMemsetAsync((char*)d_ws + WS_CTL, 0, CTL_ZERO_BYTES, stream);
    Args a{};
    for (int i = 0; i < 15; ++i) a.in[i] = (const float*)d_in[i];
    a.out = (float*)d_out; a.ws = (unsigned char*)d_ws;
#if MK_ONE_LAUNCH
    a.ph_lo = 0; a.ph_hi = N_PHASES; a.use_bar = 1;
    hipLaunchKernelGGL(mk_fwd, dim3(grid), dim3(512), LDS_BYTES, stream, a);
#else
    for (int p = 0; p < N_PHASES; ++p) { a.ph_lo = p; a.ph_hi = p + 1; a.use_bar = 0; hipLaunchKernelGGL(mk_fwd, dim3(grid), dim3(512), LDS_BYTES, stream, a); }
#endif
}
```

```cpp
#include <hip/hip_runtime.h>
#include <cstdio>
#include <cstdint>
namespace pg8 {
#define PG8_LAS __attribute__((address_space(3)))
typedef unsigned short bf16_t;
typedef short bf16x8 __attribute__((ext_vector_type(8)));
typedef float f32x4 __attribute__((ext_vector_type(4)));
typedef unsigned u32x4 __attribute__((ext_vector_type(4)));
constexpr int BM = 256, BK = 64, HALF = 128, HTB = HALF * BK * 2  , STAGE_BYTES = 8 * HTB, NXCD = 8, WGM = 8;

__host__ __device__ __forceinline__ int lds_byte(int r, int c) { const int st = (r >> 4) * 2 + (c >> 5), rr = r & 15, cc = c & 31, ob = rr * 64 + cc * 2; return st * 1024 + (ob ^ (((ob >> 9) & 1) << 5)); }
__host__ __device__ __forceinline__ void stage_rc(int b, int& R, int& C) { const int st = b / 1024, sb = b % 1024, swz = sb ^ (((sb >> 9) & 1) << 5); R = (st >> 1) * 16 + swz / 64; C = (st & 1) * 32 + (swz % 64) / 2; }
__host__ __device__ __forceinline__ int perm32(int rho) { const int n = rho >> 4, i = rho & 15; return 8 * (i >> 2) + 4 * n + (i & 3); }

struct Unit { int pm, pn; };
struct Gemm { const bf16_t* A; const bf16_t* Bt; int M, N, K; };

struct StaticOrder {
    int nM, nN, nwg, G, c;
    __host__ __device__ __forceinline__ void init(int M, int N, int G_, int c_) { nM = M / BM; nN = N / BM; nwg = nM * nN; G = G_; c = c_; }
    __host__ __device__ __forceinline__ bool next(int i, Unit& u) const {
        const long L = (long)i * G + c; if (L >= nwg) return false;
        int wgid = (int)L; { const int q = nwg / NXCD, r = nwg % NXCD, xcd = wgid % NXCD, off = wgid / NXCD; wgid = (xcd < r ? xcd * (q + 1) : r * (q + 1) + (xcd - r) * q) + off; }
        const int nig = WGM * nN, gid = wgid / nig, fm = gid * WGM, gsz = (nM - fm) < WGM ? (nM - fm) : WGM;
        u.pm = fm + ((wgid % nig) % gsz); u.pn = (wgid % nig) / gsz; return true;
    }
    __device__ __forceinline__ void a_ready(const Unit&) const {}
    __device__ __forceinline__ void done(const Unit&) const {}
};

__device__ __forceinline__ unsigned cvt_pk_bf16(float lo, float hi) { unsigned r; asm volatile("v_cvt_pk_bf16_f32 %0, %1, %2" : "=v"(r) : "v"(lo), "v"(hi)); return r; }
typedef float f32x2 __attribute__((ext_vector_type(2)));
typedef unsigned u32x2 __attribute__((ext_vector_type(2)));
constexpr float RMS_EPS = 1e-6f;
__device__ __forceinline__ float rstd_of_row(const float* p) {
    f32x4 s = *(const f32x4*)p;
#pragma unroll
    for (int i = 1; i < 8; ++i) s += *(const f32x4*)(p + 4 * i);
    return rsqrtf(((s[0] + s[1]) + (s[2] + s[3])) * (1.0f / 2048.0f) + RMS_EPS);
}
struct RsTab { PG8_LAS const float* tab; int pm0, pm1, pm2, pm3; const float* ps;
    __device__ __forceinline__ int slot(int pm) const { return pm == pm0 ? 0 : pm == pm1 ? 1 : pm == pm2 ? 2 : pm == pm3 ? 3 : -1; }
    __device__ __forceinline__ void get8(int pm, int wr, int fr, float (&rs)[2][4]) const { const int sl = slot(pm);
        if (sl >= 0) { PG8_LAS const float* t = tab + sl * 256 + wr * 64 + fr;
#pragma unroll
            for (int ai = 0; ai < 2; ++ai)
#pragma unroll
                for (int m = 0; m < 4; ++m) rs[ai][m] = t[ai * HALF + m * 16]; }
        else { const float* q = ps + (size_t)(pm * BM + wr * 64 + fr) * 32;
#pragma unroll
            for (int ai = 0; ai < 2; ++ai)
#pragma unroll
                for (int m = 0; m < 4; ++m) rs[ai][m] = rstd_of_row(q + (size_t)(ai * HALF + m * 16) * 32); } } };
struct EpiProj {
    static constexpr int PERM = 3; static constexpr bool AFTER_DRAIN = false;
    bf16_t* P; float* gates; RsTab rt; const float* gate_b;
    __device__ __forceinline__ void operator()(const f32x4 (&acc)[2][2][4][2], const Unit& u, int wr, int wc, int fr, int fq) const {
        const int row0 = u.pm * BM + wr * 64 + fr; float rs8[2][4]; rt.get8(u.pm, wr, fr, rs8);
        if (u.pn < 28) {
            const int col0 = u.pn * BM + wc * 64 + 8 * fq;
#pragma unroll
            for (int ai = 0; ai < 2; ++ai)
#pragma unroll
                for (int m = 0; m < 4; ++m) { const int r = row0 + ai * HALF + m * 16; const float rs = rs8[ai][m];
                    bf16_t* rowp = P + (size_t)r * 7168 + col0;
#pragma unroll
                    for (int bj = 0; bj < 2; ++bj) { const f32x4 v0 = acc[ai][bj][m][0] * rs, v1 = acc[ai][bj][m][1] * rs;
                        u32x4 w; w.x = cvt_pk_bf16(v0[0], v0[1]); w.y = cvt_pk_bf16(v0[2], v0[3]); w.z = cvt_pk_bf16(v1[0], v1[1]); w.w = cvt_pk_bf16(v1[2], v1[3]);
                        __builtin_nontemporal_store(w, (u32x4*)(rowp + bj * 32)); } }
        } else if (wc == 0 && fq < 2) {
#pragma unroll
            for (int ai = 0; ai < 2; ++ai)
#pragma unroll
                for (int m = 0; m < 4; ++m) { const int r = row0 + ai * HALF + m * 16; const float rs = rs8[ai][m];
                    float* gp = gates + (size_t)r * 16 + 8 * fq;
#pragma unroll
                    for (int n = 0; n < 2; ++n) *(f32x4*)(gp + 4 * n) = acc[ai][0][m][n] * rs + *(const f32x4*)(gate_b + 8 * fq + 4 * n); }
        }
    }
};
#ifndef MK_RESID_LO
#define MK_RESID_LO 2
#endif
struct EpiResid {
    static constexpr int PERM = 3; static constexpr bool AFTER_DRAIN = false;
    bf16_t* xh; bf16_t* xl; float* ps; float sign; int do_ss; int rd_lo, wr_lo;
    __device__ __forceinline__ void operator()(const f32x4 (&acc)[2][2][4][2], const Unit& u, int wr, int wc, int fr, int fq) const {
        const int row0 = u.pm * BM + wr * 64 + fr, col0 = u.pn * BM + wc * 64 + 8 * fq;
#pragma unroll
        for (int ai = 0; ai < 2; ++ai) {
            u32x4 vh[4][2], vl[4][2];
#pragma unroll
            for (int m = 0; m < 4; ++m)
#pragma unroll
                for (int bj = 0; bj < 2; ++bj) { const size_t o = (size_t)(row0 + ai * HALF + m * 16) * 2048 + col0 + bj * 32; vh[m][bj] = *(const u32x4*)(xh + o);
                    if (rd_lo) vl[m][bj] = *(const u32x4*)(xl + o); else vl[m][bj] = (u32x4){0u, 0u, 0u, 0u}; }
#pragma unroll
            for (int m = 0; m < 4; ++m) { const int r = row0 + ai * HALF + m * 16; const size_t off = (size_t)r * 2048 + col0; float ss = 0.f;
#pragma unroll
                for (int bj = 0; bj < 2; ++bj) { const u32x4 h4 = vh[m][bj], l4 = vl[m][bj]; u32x4 wh, wl;
#pragma unroll
                    for (int n = 0; n < 2; ++n) { const unsigned hx = n ? h4.z : h4.x, hy = n ? h4.w : h4.y, lx = n ? l4.z : l4.x, ly = n ? l4.w : l4.y;
                        f32x4 v;
                        v[0] = __uint_as_float(hx << 16) + __uint_as_float(lx << 16); v[1] = __uint_as_float(hx & 0xffff0000u) + __uint_as_float(lx & 0xffff0000u);
                        v[2] = __uint_as_float(hy << 16) + __uint_as_float(ly << 16); v[3] = __uint_as_float(hy & 0xffff0000u) + __uint_as_float(ly & 0xffff0000u);
                        v = v + acc[ai][bj][m][n] * sign;
                        ss += (v[0] * v[0] + v[1] * v[1]) + (v[2] * v[2] + v[3] * v[3]);
                        const unsigned w0 = cvt_pk_bf16(v[0], v[1]), w1 = cvt_pk_bf16(v[2], v[3]);
                        const unsigned q0 = cvt_pk_bf16(v[0] - __uint_as_float(w0 << 16), v[1] - __uint_as_float(w0 & 0xffff0000u)), q1 = cvt_pk_bf16(v[2] - __uint_as_float(w1 << 16), v[3] - __uint_as_float(w1 & 0xffff0000u));
                        if (n == 0) { wh.x = w0; wh.y = w1; wl.x = q0; wl.y = q1; } else { wh.z = w0; wh.w = w1; wl.z = q0; wl.w = q1; } }
                    *(u32x4*)(xh + off + bj * 32) = wh;
                    if (wr_lo) *(u32x4*)(xl + off + bj * 32) = wl; }
                ss += __shfl_xor(ss, 16); ss += __shfl_xor(ss, 32);
                if (fq == 0 && do_ss) ps[(size_t)r * 32 + u.pn * 4 + wc] = ss; }
            asm volatile("" ::: "memory");
        }
    }
};
__device__ __forceinline__ float dpp_shr1(float old, float src) { return __builtin_bit_cast(float, __builtin_amdgcn_update_dpp(__builtin_bit_cast(int, old), __builtin_bit_cast(int, src), 0x111, 0xf, 0xf, false)); }
__device__ __forceinline__ float dpp_shl1(float old, float src) { return __builtin_bit_cast(float, __builtin_amdgcn_update_dpp(__builtin_bit_cast(int, old), __builtin_bit_cast(int, src), 0x101, 0xf, 0xf, false)); }
__device__ __forceinline__ float dpp_ror1(float src) { return __builtin_bit_cast(float, __builtin_amdgcn_mov_dpp(__builtin_bit_cast(int, src), 0x121, 0xf, 0xf, true)); }
__device__ __forceinline__ float dpp_rol1(float src) { return __builtin_bit_cast(float, __builtin_amdgcn_mov_dpp(__builtin_bit_cast(int, src), 0x12F, 0xf, 0xf, true)); }
struct EpiGlu {
    static constexpr int PERM = 1; static constexpr bool AFTER_DRAIN = false;
    static constexpr int DFF_ = 5632, NUP_ = 11264;
    bf16_t* act; float* HB; RsTab rt; const float* cw; const float* cb; PG8_LAS unsigned char* hl;
    __device__ __forceinline__ void operator()(const f32x4 (&acc)[2][2][4][2], const Unit& u, int wr, int wc, int fr, int fq) const {
        const int row0 = u.pm * BM + wr * 64 + fr, cl = wc * 32 + 8 * fq;
        float rs[2][4]; rt.get8(u.pm, wr, fr, rs);
        f32x4 pw[8];
        { const int col = u.pn * 128 + cl; pw[0] = *(const f32x4*)(cw + col); pw[1] = *(const f32x4*)(cw + NUP_ + col); pw[2] = *(const f32x4*)(cw + 2 * NUP_ + col); pw[3] = *(const f32x4*)(cb + col);
          pw[4] = *(const f32x4*)(cw + DFF_ + col); pw[5] = *(const f32x4*)(cw + NUP_ + DFF_ + col); pw[6] = *(const f32x4*)(cw + 2 * NUP_ + DFF_ + col); pw[7] = *(const f32x4*)(cb + DFF_ + col); }
        if (fr == 0 || fr == 15) {
#pragma unroll
            for (int ai = 0; ai < 2; ++ai) { const int slot = 2 * (2 * ai + wr) + (fr == 15 ? 1 : 0); const float rsv = fr == 15 ? rs[ai][3] : rs[ai][0];
#pragma unroll
                for (int bj = 0; bj < 2; ++bj)
#pragma unroll
                    for (int n = 0; n < 2; ++n) { const f32x4 a0 = fr == 15 ? acc[ai][bj][3][n] : acc[ai][bj][0][n];
                        *(PG8_LAS f32x4*)(hl + slot * 1024 + (bj * 128 + cl + 4 * n) * 4) = a0 * rsv; } }
        }
        if ((wr == 0 && fr < 2) || (wr == 1 && fr >= 14)) {
            const int ai = wr, rowslot = wr ? (fr - 12) : fr;
            float* hb = HB + (size_t)(u.pm * 4 + rowslot) * NUP_ + u.pn * 128 + cl;
#pragma unroll
            for (int bj = 0; bj < 2; ++bj)
#pragma unroll
                for (int n = 0; n < 2; ++n) { const f32x4 a0 = ai ? acc[1][bj][3][n] : acc[0][bj][0][n]; *(f32x4*)(hb + bj * DFF_ + 4 * n) = a0 * (ai ? rs[1][3] : rs[0][0]); }
        }
        asm volatile("s_waitcnt lgkmcnt(0)" ::: "memory"); __builtin_amdgcn_s_barrier(); asm volatile("" ::: "memory");
        u32x2 keep[2][4];
#pragma unroll
        for (int n = 0; n < 2; ++n) {
            const int col = u.pn * 128 + cl + 4 * n;
            const f32x4 w0g = n ? *(const f32x4*)(cw + col) : pw[0], w1g = n ? *(const f32x4*)(cw + NUP_ + col) : pw[1], w2g = n ? *(const f32x4*)(cw + 2 * NUP_ + col) : pw[2], bg = n ? *(const f32x4*)(cb + col) : pw[3];
            const f32x4 w0v = n ? *(const f32x4*)(cw + DFF_ + col) : pw[4], w1v = n ? *(const f32x4*)(cw + NUP_ + DFF_ + col) : pw[5], w2v = n ? *(const f32x4*)(cw + 2 * NUP_ + DFF_ + col) : pw[6], bv = n ? *(const f32x4*)(cb + DFF_ + col) : pw[7];
#pragma unroll
            for (int ai = 0; ai < 2; ++ai) {
                const int sg = 2 * ai + wr;
                f32x4 Ug[4], Uv[4];
#pragma unroll
                for (int m = 0; m < 4; ++m) { Ug[m] = acc[ai][0][m][n] * rs[ai][m]; Uv[m] = acc[ai][1][m][n] * rs[ai][m]; }
                f32x4 hug = (f32x4){0.f, 0.f, 0.f, 0.f}, huv = hug, hdg = hug, hdv = hug;
                if (sg > 0) { PG8_LAS const unsigned char* p = hl + (2 * (sg - 1) + 1) * 1024 + (cl + 4 * n) * 4; hug = *(PG8_LAS const f32x4*)p; huv = *(PG8_LAS const f32x4*)(p + 512); }
                if (sg < 3) { PG8_LAS const unsigned char* p = hl + (2 * (sg + 1)) * 1024 + (cl + 4 * n) * 4;     hdg = *(PG8_LAS const f32x4*)p; hdv = *(PG8_LAS const f32x4*)(p + 512); }
#pragma unroll
                for (int m = 0; m < 4; ++m) {
                    float z[4];
#pragma unroll
                    for (int j = 0; j < 4; ++j) {
                        const float sug = m > 0 ? dpp_ror1(Ug[m - 1][j]) : hug[j], suv = m > 0 ? dpp_ror1(Uv[m - 1][j]) : huv[j];
                        const float sdg = m < 3 ? dpp_rol1(Ug[m + 1][j]) : hdg[j], sdv = m < 3 ? dpp_rol1(Uv[m + 1][j]) : hdv[j];
                        const float upg = dpp_shr1(sug, Ug[m][j]), dng = dpp_shl1(sdg, Ug[m][j]), upv = dpp_shr1(suv, Uv[m][j]), dnv = dpp_shl1(sdv, Uv[m][j]);
                        const float g = bg[j] + w0g[j] * upg + w1g[j] * Ug[m][j] + w2g[j] * dng, vv = bv[j] + w0v[j] * upv + w1v[j] * Uv[m][j] + w2v[j] * dnv;
                        z[j] = g * __builtin_amdgcn_rcpf(1.0f + __expf(-g)) * vv;
                    }
                    u32x2 w; w.x = cvt_pk_bf16(z[0], z[1]); w.y = cvt_pk_bf16(z[2], z[3]);
                    if (n == 0) keep[ai][m] = w;
                    else { u32x4 o; o.x = keep[ai][m].x; o.y = keep[ai][m].y; o.z = w.x; o.w = w.y; __builtin_nontemporal_store(o, (u32x4*)(act + (size_t)(row0 + ai * HALF + m * 16) * DFF_ + u.pn * 128 + cl)); }
                }
            }
        }
    }
};
template <class Epi, class Sched, bool ALIGN_EPI = false, bool SP2 = false>
__device__ __forceinline__ void gemm_phase(PG8_LAS unsigned char* lds, const Gemm g, const Sched& S, const Epi& E, unsigned long long* tim = nullptr) {
    int tid = threadIdx.x; asm volatile("" : "+v"(tid));
    const int wid = __builtin_amdgcn_readfirstlane(tid >> 6), lane = tid & 63, wr = wid >> 2, wc = wid & 3, fr = lane & 15, fq = lane >> 4;
    const int K = g.K, nt = K / BK;
    unsigned voffA[2], voffB[2];
#pragma unroll
    for (int i = 0; i < 2; ++i) { int R, C; stage_rc(tid * 16 + i * 8192, R, C);
        const int Rb = (int)Epi::PERM == 3 ? (64 * (R >> 5) + 8 * ((R & 15) >> 2) + 4 * ((R >> 4) & 1) + (R & 3)) : (int)Epi::PERM == 2 ? (64 * (R >> 5) + 16 * ((R & 15) >> 2) + 4 * ((R >> 4) & 1) + (R & 3)) : ((int)Epi::PERM == 1 ? ((R & ~31) + perm32(R & 31)) : R);
        voffA[i] = (unsigned)(R * K + C) * 2u; voffB[i] = (unsigned)(Rb * K + C) * 2u; }
    const size_t kstep = (size_t)(BK * 2);
    const size_t hstep = (size_t)HALF * K * 2;
    const size_t hstepB = (int)Epi::PERM == 3 ? (size_t)32 * K * 2 : (int)Epi::PERM == 2 ? (size_t)8 * K * 2 : hstep;
    const size_t tstep = 2 * hstep;
    const unsigned ldsw = (unsigned)wid * 1024u;
    const int aoff = lds_byte(wr * 64 + fr, fq * 8), boff = lds_byte(wc * 32 + fr, fq * 8);
#define PG8_SA(b, h) (((b) * 2 + (h)) * HTB)
#define PG8_SB(b, h) ((4 + (b) * 2 + (h)) * HTB)
#define PG8_STAGE(bufoff, gbase, voff) do { _Pragma("unroll") for (int _i = 0; _i < 2; ++_i) \
        __builtin_amdgcn_global_load_lds((const unsigned*)((const char*)(gbase) + (voff)[_i]), (PG8_LAS unsigned*)(lds + (bufoff) + ldsw + _i * 8192), 16, 0, 0); } while (0)
#define PG8_LDA(dst, b, h) do { _Pragma("unroll") for (int m = 0; m < 4; ++m) _Pragma("unroll") for (int k = 0; k < 2; ++k) dst[m][k] = *(const PG8_LAS bf16x8*)(lds + PG8_SA(b, h) + aoff + m * 2048 + k * 1024); } while (0)
#define PG8_LDB(dst, b, h) do { _Pragma("unroll") for (int n = 0; n < 2; ++n) _Pragma("unroll") for (int k = 0; k < 2; ++k) dst[n][k] = *(const PG8_LAS bf16x8*)(lds + PG8_SB(b, h) + boff + n * 2048 + k * 1024); } while (0)
#define PG8_MMA(ai, bj, At, Bt) do { __builtin_amdgcn_s_setprio(1); _Pragma("unroll") for (int m = 0; m < 4; ++m) _Pragma("unroll") for (int n = 0; n < 2; ++n) _Pragma("unroll") for (int k = 0; k < 2; ++k) \
        acc[ai][bj][m][n] = __builtin_amdgcn_mfma_f32_16x16x32_bf16(Bt[n][k], At[m][k], acc[ai][bj][m][n], 0, 0, 0); __builtin_amdgcn_s_setprio(0); } while (0)
#define PG8_WAIT_V(n) asm volatile("s_waitcnt vmcnt(" #n ")" ::: "memory")
#define PG8_WAIT_L(n) asm volatile("s_waitcnt lgkmcnt(" #n ")" ::: "memory")
#define PG8_BAR __builtin_amdgcn_s_barrier()
#define PG8_SCHED __builtin_amdgcn_sched_barrier(0)
    Unit cur, nxt; int ui = 0;
    if (!S.next(0, cur)) return;
    f32x4 acc[2][2][4][2];
#pragma unroll
    for (int a = 0; a < 2; ++a)
#pragma unroll
        for (int b = 0; b < 2; ++b)
#pragma unroll
            for (int m = 0; m < 4; ++m)
#pragma unroll
                for (int n = 0; n < 2; ++n) acc[a][b][m][n] = (f32x4){0.f, 0.f, 0.f, 0.f};
    bf16x8 At[4][2], B0[2][2], B1[2][2];
    const char* cA = (const char*)g.A + (size_t)cur.pm * tstep; const char* cB = (const char*)g.Bt + (size_t)cur.pn * tstep;
    S.a_ready(cur);
    if constexpr (SP2) {
        PG8_STAGE(PG8_SB(0, 0), cB, voffB); PG8_STAGE(PG8_SB(0, 1), cB + hstepB, voffB); PG8_STAGE(PG8_SA(0, 0), cA, voffA); PG8_STAGE(PG8_SA(0, 1), cA + hstep, voffA);
        if (wr == 1) PG8_BAR;
        PG8_WAIT_V(2); PG8_BAR;
        PG8_STAGE(PG8_SB(1, 0), cB + kstep, voffB); PG8_STAGE(PG8_SA(1, 0), cA + kstep, voffA); PG8_STAGE(PG8_SB(1, 1), cB + hstepB + kstep, voffB);
        PG8_WAIT_V(6); PG8_BAR;
    } else {
        PG8_STAGE(PG8_SB(0, 0), cB, voffB); PG8_STAGE(PG8_SA(0, 0), cA, voffA); PG8_STAGE(PG8_SB(0, 1), cB + hstepB, voffB); PG8_STAGE(PG8_SA(0, 1), cA + hstep, voffA);
        if (wr == 1) PG8_BAR;
        PG8_WAIT_V(4); PG8_BAR;
        PG8_STAGE(PG8_SB(1, 0), cB + kstep, voffB); PG8_STAGE(PG8_SA(1, 0), cA + kstep, voffA); PG8_STAGE(PG8_SB(1, 1), cB + hstepB + kstep, voffB);
        PG8_WAIT_V(6); PG8_BAR;
    }
    if (tim) { tim[2] = __builtin_amdgcn_s_memrealtime(); asm volatile("s_waitcnt lgkmcnt(0)" ::: "memory"); }
    for (;;) {
        const bool has_next = S.next(ui + 1, nxt);
        const char* nA = has_next ? (const char*)g.A + (size_t)nxt.pm * tstep : cA; const char* nB = has_next ? (const char*)g.Bt + (size_t)nxt.pn * tstep : cB;
        for (int t = 0; t < nt; t += 2) {
            const bool last = (t == nt - 2);
            const char* a1 = cA + (size_t)(t + 1) * kstep;
            const char* a2 = last ? nA : cA + (size_t)(t + 2) * kstep; const char* b2 = last ? nB : cB + (size_t)(t + 2) * kstep;
            const char* a3 = a2 + kstep; const char* b3 = b2 + kstep;
            if (last && has_next) S.a_ready(nxt);
            if constexpr (SP2) {
            PG8_LDB(B0, 0, 0); PG8_LDB(B1, 0, 1); PG8_SCHED; PG8_LDA(At, 0, 0); PG8_STAGE(PG8_SA(1, 1), a1 + hstep, voffA);
            PG8_WAIT_V(8); PG8_WAIT_L(0); PG8_BAR; PG8_MMA(0, 0, At, B0); PG8_MMA(0, 1, At, B1); PG8_BAR; PG8_SCHED;
            PG8_LDA(At, 0, 1); PG8_STAGE(PG8_SB(0, 0), b2, voffB); PG8_STAGE(PG8_SB(0, 1), b2 + hstepB, voffB); PG8_STAGE(PG8_SA(0, 0), a2, voffA);
            PG8_WAIT_V(8); PG8_WAIT_L(0); PG8_BAR; PG8_MMA(1, 0, At, B0); PG8_MMA(1, 1, At, B1); PG8_BAR; PG8_SCHED;
            PG8_LDB(B0, 1, 0); PG8_LDB(B1, 1, 1); PG8_SCHED; PG8_LDA(At, 1, 0); PG8_STAGE(PG8_SA(0, 1), a2 + hstep, voffA);
            PG8_WAIT_V(8); PG8_WAIT_L(0); PG8_BAR; PG8_MMA(0, 0, At, B0); PG8_MMA(0, 1, At, B1); PG8_BAR; PG8_SCHED;
            PG8_LDA(At, 1, 1); PG8_STAGE(PG8_SB(1, 0), b3, voffB); PG8_STAGE(PG8_SB(1, 1), b3 + hstepB, voffB); PG8_STAGE(PG8_SA(1, 0), a3, voffA);
            PG8_WAIT_V(8); PG8_WAIT_L(0); PG8_BAR; PG8_MMA(1, 0, At, B0); PG8_MMA(1, 1, At, B1); PG8_BAR; PG8_SCHED;
            } else {
            PG8_LDB(B0, 0, 0); PG8_SCHED; PG8_LDA(At, 0, 0); PG8_STAGE(PG8_SA(1, 1), a1 + hstep, voffA);
            PG8_WAIT_L(8); PG8_BAR; PG8_WAIT_L(0); PG8_MMA(0, 0, At, B0); PG8_BAR; PG8_SCHED;
            PG8_LDB(B1, 0, 1); PG8_STAGE(PG8_SB(0, 0), b2, voffB);
            PG8_BAR; PG8_WAIT_L(0); PG8_MMA(0, 1, At, B1); PG8_BAR;
            PG8_LDA(At, 0, 1); PG8_STAGE(PG8_SA(0, 0), a2, voffA);
            PG8_BAR; PG8_WAIT_L(0); PG8_MMA(1, 0, At, B0); PG8_BAR; PG8_SCHED;
            PG8_STAGE(PG8_SB(0, 1), b2 + hstepB, voffB);
            PG8_WAIT_V(6); PG8_BAR; PG8_MMA(1, 1, At, B1); PG8_BAR;
            PG8_LDB(B0, 1, 0); PG8_SCHED; PG8_LDA(At, 1, 0); PG8_STAGE(PG8_SA(0, 1), a2 + hstep, voffA);
            PG8_WAIT_L(8); PG8_BAR; PG8_WAIT_L(0); PG8_MMA(0, 0, At, B0); PG8_BAR; PG8_SCHED;
            PG8_LDB(B1, 1, 1); PG8_STAGE(PG8_SB(1, 0), b3, voffB);
            PG8_BAR; PG8_WAIT_L(0); PG8_MMA(0, 1, At, B1); PG8_BAR;
            PG8_LDA(At, 1, 1); PG8_STAGE(PG8_SA(1, 0), a3, voffA);
            PG8_BAR; PG8_WAIT_L(0); PG8_MMA(1, 0, At, B0); PG8_BAR; PG8_SCHED;
            PG8_STAGE(PG8_SB(1, 1), b3 + hstepB, voffB);
            PG8_WAIT_V(6); PG8_BAR; PG8_MMA(1, 1, At, B1); PG8_BAR;
            }
        }
        if constexpr (ALIGN_EPI) { if (wr == 0) PG8_BAR; }
        unsigned long long ts_ = 0ull; if (tim) { ts_ = __builtin_amdgcn_s_memrealtime(); asm volatile("s_waitcnt lgkmcnt(0)" ::: "memory"); tim[0] += ts_ - tim[2]; }
        if constexpr (!Epi::AFTER_DRAIN) { E(acc, cur, wr, wc, fr, fq); S.done(cur); }
        if (tim) { const unsigned long long te_ = __builtin_amdgcn_s_memrealtime(); asm volatile("s_waitcnt lgkmcnt(0)" ::: "memory"); tim[1] += te_ - ts_; tim[2] = te_; }
        if (!has_next) break;
#pragma unroll
        for (int a = 0; a < 2; ++a)
#pragma unroll
            for (int b = 0; b < 2; ++b)
#pragma unroll
                for (int m = 0; m < 4; ++m)
#pragma unroll
                    for (int n = 0; n < 2; ++n) acc[a][b][m][n] = (f32x4){0.f, 0.f, 0.f, 0.f};
        cur = nxt; cA = nA; cB = nB; ++ui;
        if constexpr (ALIGN_EPI) { if (wr == 1) PG8_BAR; }
    }
    PG8_WAIT_V(0);
    if constexpr (!ALIGN_EPI) { if (wr == 0) PG8_BAR; }
    PG8_BAR;
    if constexpr (Epi::AFTER_DRAIN) { E.fused(acc, cur, wr, wc, fr, fq, lds, wid, lane); S.done(cur); }
#undef PG8_SA
#undef PG8_SB
#undef PG8_STAGE
#undef PG8_LDA
#undef PG8_LDB
#undef PG8_MMA
#undef PG8_WAIT_V
#undef PG8_WAIT_L
#undef PG8_BAR
#undef PG8_SCHED
}
}
#define GAS __attribute__((address_space(1)))
#define LAS __attribute__((address_space(3)))
typedef unsigned short bf16;
typedef unsigned v4u __attribute__((ext_vector_type(4)));
typedef float f32x4 __attribute__((ext_vector_type(4)));
typedef short bf16x8 __attribute__((ext_vector_type(8)));
typedef GAS unsigned gu32;
typedef GAS unsigned long long gu64;
#define RLX_AGENT __ATOMIC_RELAXED, __HIP_MEMORY_SCOPE_AGENT
#define LDS_WAIT() asm volatile("s_waitcnt lgkmcnt(0)" ::: "memory")
#define VM_WAIT() asm volatile("s_waitcnt vmcnt(0)" ::: "memory")
__device__ __forceinline__ unsigned long long rt() { return __builtin_amdgcn_s_memrealtime(); }
__device__ __forceinline__ unsigned f2bf(float f) { unsigned u = __builtin_bit_cast(unsigned, f); return (u + 0x7fffu + ((u >> 16) & 1u)) >> 16; }
__device__ __forceinline__ unsigned pk2(float lo, float hi) { return f2bf(lo) | (f2bf(hi) << 16); }

#define XB_TMO      128
#define XB_XCNT(j)  (256  + 64 * (j))
#define XB_XSUB(j)  (1280 + 64 * (j))
#define XB_XGEN(j)  (2304 + 64 * (j))
#define XB_TOP      3328
#define XB_TOPGEN   3392
#define XCD_BAR_WORDS 3456
#define XB_SPIN_CAP (1u << 18)

__device__ __forceinline__ unsigned xb_ld(unsigned* p)              { return __hip_atomic_load(p, __ATOMIC_RELAXED, __HIP_MEMORY_SCOPE_AGENT); }
__device__ __forceinline__ unsigned xb_add(unsigned* p, unsigned v) { return __hip_atomic_fetch_add(p, v, __ATOMIC_RELAXED, __HIP_MEMORY_SCOPE_AGENT); }
__device__ __forceinline__ unsigned xb_xcc_id() { return (unsigned)__builtin_amdgcn_s_getreg((3 << 11) | 20) & 0xFu; }
#define XB_SPIN(cond, bar) do { unsigned _sp = 0; while (cond) { __builtin_amdgcn_s_sleep(1); \
    if ((++_sp & 255u) == 0u) { if (xb_ld(&(bar)[XB_TMO])) break; if (_sp > XB_SPIN_CAP) { atomicAdd(&(bar)[XB_TMO], 1u); break; } } } } while (0)

struct XcdBarrier {
    unsigned* bar; unsigned x;
    volatile LAS unsigned* st;
};

__device__ __forceinline__ XcdBarrier xcd_barrier_post(unsigned* bar, volatile LAS unsigned* st) {
    XcdBarrier b; b.bar = bar; b.x = xb_xcc_id(); b.st = st;
    if (threadIdx.x == 0) (void)xb_add(&bar[XB_XCNT(b.x)], 1u);
    return b;
}
__device__ __forceinline__ void xcd_barrier_complete(unsigned* bar, unsigned x, unsigned& nloc, unsigned& nx) {
    const unsigned G = gridDim.x * gridDim.y * gridDim.z;
    unsigned sum, cnt, mine, sp = 0u;
    for (;;) {
        sum = 0u; cnt = 0u; mine = 0u;
#pragma unroll
        for (unsigned j = 0; j < 16; ++j) { const unsigned c = xb_ld(&bar[XB_XCNT(j)]); sum += c; cnt += (c > 0u) ? 1u : 0u; mine = (j == x) ? c : mine; }
        if (sum == G) break;
        __builtin_amdgcn_s_sleep(1);
        if ((++sp & 255u) == 0u) { if (xb_ld(&bar[XB_TMO])) break; if (sp > XB_SPIN_CAP) { atomicAdd(&bar[XB_TMO], 1u); break; } }
    }
    nloc = mine > 0u ? mine : 1u; nx = cnt > 0u ? cnt : 1u;
}

__device__ __forceinline__ void xcd_barrier(const XcdBarrier& b) {
    asm volatile("s_waitcnt vmcnt(0)" ::: "memory");
    __syncthreads();
    if (threadIdx.x == 0) {
        unsigned* bar = b.bar;
        __builtin_amdgcn_s_waitcnt(0);
        unsigned nloc = b.st[0], nx = b.st[1];
        if (nloc == 0u) { xcd_barrier_complete(bar, b.x, nloc, nx); b.st[0] = nloc; b.st[1] = nx; }
        const unsigned old = xb_add(&bar[XB_XSUB(b.x)], 1u);
        const unsigned gen = old / nloc;
        if (old + 1u == (gen + 1u) * nloc) {
            __builtin_amdgcn_fence(__ATOMIC_RELEASE, "agent");
            asm volatile("s_waitcnt vmcnt(0)" ::: "memory");
            const unsigned og = xb_add(&bar[XB_TOP], 1u);
            const unsigned tg = og / nx;
            if (og + 1u == (tg + 1u) * nx) xb_add(&bar[XB_TOPGEN], 1u);
            else XB_SPIN(xb_ld(&bar[XB_TOPGEN]) == tg, bar);
            __builtin_amdgcn_fence(__ATOMIC_ACQUIRE, "agent");
            xb_add(&bar[XB_XGEN(b.x)], 1u);
            asm volatile("s_waitcnt vmcnt(0)" ::: "memory");
        } else {
            XB_SPIN(xb_ld(&bar[XB_XGEN(b.x)]) == gen, bar);
            __builtin_amdgcn_fence(__ATOMIC_ACQUIRE, "agent");
            asm volatile("s_waitcnt vmcnt(0)" ::: "memory");
        }
    }
    __syncthreads();
}
constexpr int T = 24576, D = 2048, DEPTH = 4, NIN = 7184, NINP = 7424, PROJW = 7168, DFF = 5632, NUP = 11264;
constexpr int NCHUNK = 192;
constexpr float EPS = 1e-6f;
constexpr size_t MiB = 1u << 20;
constexpr size_t WS_CTL = 0, CTL_ZERO_BYTES = 1 * MiB;
constexpr size_t WS_W = 3 * MiB, W_BUF = 103 * MiB;
constexpr size_t WO_IN = 0, WO_OUT = (size_t)NINP * D * 2, WO_UP = WO_OUT + (size_t)D * D * 2, WO_DOWN = WO_UP + (size_t)NUP * D * 2;
constexpr size_t WS_X = 209 * MiB;
constexpr size_t WS_XB = 401 * MiB;
constexpr size_t WS_PROJ = 497 * MiB;
constexpr size_t WS_S = 833 * MiB;
constexpr size_t WS_MIX = 1025 * MiB;
constexpr size_t WS_ACT = 1025 * MiB;
constexpr size_t WS_SM = 1289 * MiB;
constexpr size_t WS_GATES = WS_SM, WS_BQ = WS_SM + 2 * MiB, WS_BK = WS_SM + 3 * MiB, WS_KMAX = WS_SM + 4 * MiB, WS_BLAST = WS_KMAX + 8192, WS_US = WS_KMAX + 16384, WS_DN = WS_SM + 5 * MiB;
constexpr size_t WS_HB = 1297 * MiB;
constexpr size_t WS_PS = 1315 * MiB;
constexpr size_t WS_END = 1344 * MiB;
static_assert(WO_DOWN + (size_t)D * DFF * 2 <= W_BUF && WS_W + 2 * W_BUF <= WS_X && WS_PS + (size_t)9 * T * 32 * 4 <= WS_END && WS_X + (size_t)T * D * 4 <= WS_XB && WS_XB + (size_t)T * D * 2 <= WS_PROJ, "ws map 1");
static_assert(WS_PROJ + (size_t)T * PROJW * 2 <= WS_S && WS_S + (size_t)1536 * 65536 * 2 <= WS_MIX && WS_ACT + (size_t)T * DFF * 2 <= WS_SM && WS_SM + 8 * MiB <= WS_HB && WS_HB + (size_t)96 * 4 * NUP * 4 <= WS_END, "ws map 2");
constexpr int CW_BAR = 4096;
constexpr int LDS_BYTES = 152576, MISC_OFF = LDS_BYTES - 256, HALO_OFF = 131072, RST_OFF = 147456;
constexpr int TPITCH = 528;
constexpr int VT_OFF = 0, KT_OFF = 128 * TPITCH, SC_OFF = 2 * 128 * TPITCH;
static_assert(SC_OFF + 4096 <= MISC_OFF, "lds map");

typedef short bf16x8 __attribute__((ext_vector_type(8)));
typedef short s16x4 __attribute__((ext_vector_type(4)));
typedef unsigned u32x2 __attribute__((ext_vector_type(2)));
__device__ __forceinline__ float bf2f(unsigned short b) { return __uint_as_float(((unsigned)b) << 16); }
__device__ __forceinline__ unsigned pkbf(float lo, float hi) { return pg8::cvt_pk_bf16(lo, hi); }
__device__ __forceinline__ float wave_sum(float v) {
#pragma unroll
    for (int o = 1; o < 64; o <<= 1) v += __shfl_xor(v, o);
    return v;
}
__device__ __forceinline__ s16x4 tr16(LAS const unsigned char* p) { typedef short v4i16_t __attribute__((ext_vector_type(4))); return __builtin_bit_cast(s16x4, __builtin_amdgcn_ds_read_tr16_b64_v4i16((LAS v4i16_t*)p)); }
__device__ __forceinline__ bf16x8 cat8(s16x4 a, s16x4 b) { bf16x8 r; r[0] = a[0]; r[1] = a[1]; r[2] = a[2]; r[3] = a[3]; r[4] = b[0]; r[5] = b[1]; r[6] = b[2]; r[7] = b[3]; return r; }
typedef __amdgpu_buffer_rsrc_t rsrc_t;
__device__ __forceinline__ rsrc_t mkrsrc(const void* base, unsigned nbytes) {
    const unsigned long long b = (unsigned long long)base; const unsigned lo = __builtin_amdgcn_readfirstlane((unsigned)b), hi = __builtin_amdgcn_readfirstlane((unsigned)(b >> 32));
    return __builtin_amdgcn_make_buffer_rsrc((void*)(((unsigned long long)hi << 32) | lo), 0, nbytes, 0x00020000); }
__device__ __forceinline__ v4u bld128(rsrc_t rs, unsigned voff, unsigned soff) { return __builtin_amdgcn_raw_buffer_load_b128(rs, voff, soff, 0); }
__device__ __forceinline__ u32x2 bld64(rsrc_t rs, unsigned voff, unsigned soff) { return __builtin_amdgcn_raw_buffer_load_b64(rs, voff, soff, 0); }
__device__ __forceinline__ void bst64(u32x2 v, rsrc_t rs, unsigned voff, unsigned soff) { __builtin_amdgcn_raw_buffer_store_b64(v, rs, voff, soff, 0); }
__device__ __forceinline__ int unit_of(int dir, int cg, int h) { return (dir * NCHUNK + cg) * 4 + h; }

struct Ctx {
    LAS unsigned char* lds; int tid, lane, wave, G, bid;
    const float *x_prompt, *x_sample, *norm_mix_g, *w_in, *gate_b, *conv_w, *conv_norm_g, *mlstm_norm_g, *w_out, *norm_ffn_g, *w_up, *ffn_conv_w, *ffn_conv_b, *w_down, *final_norm_g;
    float* out; unsigned char* ws;
};

__device__ __forceinline__ void phase_x0(const Ctx& C) {
    int tid_ = C.tid; asm volatile("" : "+v"(tid_)); const int lane_ = tid_ & 63;
    const int gw = C.bid * 8 + C.wave, NGW = C.G * 8;
    bf16* xl = (bf16*)(C.ws + WS_X); bf16* xh = (bf16*)(C.ws + WS_XB); float* ps0 = (float*)(C.ws + WS_PS);
    f32x4 v[8];
    if (gw < T) { const float* src = gw < 16384 ? C.x_prompt + (size_t)gw * D : C.x_sample + (size_t)(gw - 16384) * D; const f32x4* s4 = (const f32x4*)src + lane_;
#pragma unroll
        for (int j = 0; j < 8; ++j) v[j] = s4[64 * j]; }
    for (int r = gw; r < T; r += NGW) {
        f32x4 vn[8]; const int rn = r + NGW;
        if (rn < T) { const float* src = rn < 16384 ? C.x_prompt + (size_t)rn * D : C.x_sample + (size_t)(rn - 16384) * D; const f32x4* s4 = (const f32x4*)src + lane_;
#pragma unroll
            for (int j = 0; j < 8; ++j) vn[j] = s4[64 * j]; }
        float ss = 0.f;
#pragma unroll
        for (int j = 0; j < 8; ++j) ss += (v[j][0] * v[j][0] + v[j][1] * v[j][1]) + (v[j][2] * v[j][2] + v[j][3] * v[j][3]);
        ss = wave_sum(ss);
        u32x2* h2 = (u32x2*)(xh + (size_t)r * D) + lane_; u32x2* l2 = (u32x2*)(xl + (size_t)r * D) + lane_;
#pragma unroll
        for (int j = 0; j < 8; ++j) { u32x2 wh; wh.x = pkbf(v[j][0], v[j][1]); wh.y = pkbf(v[j][2], v[j][3]);
            u32x2 wl; wl.x = pkbf(v[j][0] - __uint_as_float(wh.x << 16), v[j][1] - __uint_as_float(wh.x & 0xffff0000u)); wl.y = pkbf(v[j][2] - __uint_as_float(wh.y << 16), v[j][3] - __uint_as_float(wh.y & 0xffff0000u));
            h2[64 * j] = wh; if (MK_RESID_LO) l2[64 * j] = wl; }
        if (lane_ < 32) ps0[(size_t)r * 32 + lane_] = lane_ == 0 ? ss : 0.f;
        if (rn < T) {
#pragma unroll
            for (int j = 0; j < 8; ++j) v[j] = vn[j]; }
    }
}

__device__ __forceinline__ void tr_item(const float* W, int K, int Npad, int Nsrc, bf16* WT, const float* gain, int qlo, int qhi, bool permup, LAS float* scr, int item, int lane) {
    const int nblk = Npad / 32, kb = item / nblk, nb = item % nblk, k0 = 64 * kb, n0 = 32 * nb;
    const int n = (permup ? ((n0 >> 7) & 1) * DFF + 128 * (n0 >> 8) + (n0 & 127) : n0) + (lane & 31); const float cs = (n >= qlo && n < qhi) ? 0.0625f : 1.0f;
    float wv[32];
#pragma unroll
    for (int i = 0; i < 32; ++i) { const int kk = 2 * i + (lane >> 5); wv[i] = (n < Nsrc) ? W[(size_t)(k0 + kk) * Nsrc + n] : 0.f; }
#pragma unroll
    for (int i = 0; i < 32; ++i) { const int kk = 2 * i + (lane >> 5); float w = wv[i]; if (gain) w *= gain[k0 + kk]; scr[kk * 33 + (lane & 31)] = w * cs; }
    asm volatile("s_waitcnt lgkmcnt(0)" ::: "memory");
    const int c = lane & 7;
#pragma unroll
    for (int j = 0; j < 4; ++j) { const int nn = (lane >> 3) + 8 * j; const LAS float* s = scr + (8 * c) * 33 + nn;
        v4u o; o.x = pkbf(s[0 * 33], s[1 * 33]); o.y = pkbf(s[2 * 33], s[3 * 33]); o.z = pkbf(s[4 * 33], s[5 * 33]); o.w = pkbf(s[6 * 33], s[7 * 33]);
        *(v4u*)(WT + (size_t)(n0 + nn) * K + k0 + 8 * c) = o; }
    asm volatile("s_waitcnt lgkmcnt(0)" ::: "memory");
}
__device__ __forceinline__ void phase_w(const Ctx& C, int l, int part = 0) {
    int tid_ = C.tid; asm volatile("" : "+v"(tid_)); const int lane_ = tid_ & 63; (void)lane_;
    LAS float* scr = (LAS float*)(C.lds + C.wave * 16384);
    if (part == 1 && C.bid < 128) return;
    const int gw = (part == 1 ? C.bid - 128 : C.bid) * 8 + C.wave, NGW = (part == 1 ? 128 : C.G) * 8;
    constexpr int I_IN = (D / 64) * (NINP / 32), I_OUT = (D / 64) * (D / 32), I_UP = (D / 64) * (NUP / 32), I_DOWN = (DFF / 64) * (D / 32);
    constexpr int NITEMS = I_IN + I_OUT + I_UP + I_DOWN;
    bf16* wb = (bf16*)(C.ws + WS_W + (size_t)(l & 1) * W_BUF);
    constexpr int W_SPLIT = (NITEMS * 11 / 20) & ~7;
    const int it_lo = part == 2 ? W_SPLIT : 0, it_hi = part == 1 ? W_SPLIT : NITEMS;
    for (int it = it_lo + gw; it < it_hi; it += NGW) {
        int r = it;
        if (r < I_IN) { tr_item(C.w_in + (size_t)l * D * NIN, D, NINP, NIN, (bf16*)((unsigned char*)wb + WO_IN), C.norm_mix_g + l * D, 3072, 4096, false, scr, r, lane_); continue; } r -= I_IN;
        if (r < I_OUT) { tr_item(C.w_out + (size_t)l * D * D, D, D, D, (bf16*)((unsigned char*)wb + WO_OUT), nullptr, 0, 0, false, scr, r, lane_); continue; } r -= I_OUT;
        if (r < I_UP) { tr_item(C.w_up + (size_t)l * D * NUP, D, NUP, NUP, (bf16*)((unsigned char*)wb + WO_UP), C.norm_ffn_g + l * D, 0, 0, true, scr, r, lane_); continue; } r -= I_UP;
        tr_item(C.w_down + (size_t)l * DFF * D, DFF, D, D, (bf16*)((unsigned char*)wb + WO_DOWN), nullptr, 0, 0, false, scr, r, lane_);
    }
}

__device__ __forceinline__ void unpack8(const v4u& w, float (&f)[8]) {
    f[0] = __uint_as_float(w.x << 16); f[1] = __uint_as_float(w.x & 0xffff0000u); f[2] = __uint_as_float(w.y << 16); f[3] = __uint_as_float(w.y & 0xffff0000u);
    f[4] = __uint_as_float(w.z << 16); f[5] = __uint_as_float(w.z & 0xffff0000u); f[6] = __uint_as_float(w.w << 16); f[7] = __uint_as_float(w.w & 0xffff0000u);
}
__device__ __forceinline__ void conv_loads(const bf16* proj, int t0, int c0, v4u (&a)[4][2], v4u (&b)[4][2], v4u (&cbv)[2][2]) {
    const int tlo = t0 < 16384 ? 0 : 16384 + ((t0 - 16384) & ~2047), thi = t0 < 16384 ? 16384 : tlo + 2048;
#pragma unroll
    for (int r = 0; r < 4; ++r) { const int tt = t0 - 1 + r; const bool ok = tt >= tlo && tt < thi; const bf16* rp = proj + (size_t)(ok ? tt : t0) * PROJW + c0;
#pragma unroll
        for (int hh = 0; hh < 2; ++hh) { a[r][hh] = *(const v4u*)(rp + 1024 + 8 * hh); b[r][hh] = *(const v4u*)(rp + 2048 + 8 * hh); if (!ok) { a[r][hh].x = 0u; a[r][hh].y = 0u; a[r][hh].z = 0u; a[r][hh].w = 0u; } } }
#pragma unroll
    for (int k = 0; k < 2; ++k)
#pragma unroll
        for (int hh = 0; hh < 2; ++hh) cbv[k][hh] = *(const v4u*)(proj + (size_t)(t0 + k) * PROJW + c0 + 8 * hh);
}
__device__ __forceinline__ void phase_conv(const Ctx& C, int l, int b0, int nb) {
    int tid_ = C.tid; asm volatile("" : "+v"(tid_)); const int lane_ = tid_ & 63;
    if (C.bid < b0 || C.bid >= b0 + nb) return;
    const int gw = (C.bid - b0) * 8 + C.wave, NGW = nb * 8;
    const bf16* proj = (const bf16*)(C.ws + WS_PROJ); bf16* mix = (bf16*)(C.ws + WS_MIX);
    const float* cw = C.conv_w + (size_t)l * 3 * 1024; const float* cg = C.conv_norm_g + (size_t)l * 1024;
    const int c0 = 16 * lane_;
    v4u a[4][2], b[4][2], cbv[2][2];
    if (gw < T / 2) conv_loads(proj, 2 * gw, c0, a, b, cbv);
    for (int tg = gw; tg < T / 2; tg += NGW) {
        const int t0 = 2 * tg;
        float y[2][16];
#pragma unroll
        for (int hh = 0; hh < 2; ++hh) {
            const f32x4 w0a = *(const f32x4*)(cw + c0 + 8 * hh), w0b = *(const f32x4*)(cw + c0 + 8 * hh + 4), w1a = *(const f32x4*)(cw + 1024 + c0 + 8 * hh), w1b = *(const f32x4*)(cw + 1024 + c0 + 8 * hh + 4);
            const f32x4 w2a = *(const f32x4*)(cw + 2048 + c0 + 8 * hh), w2b = *(const f32x4*)(cw + 2048 + c0 + 8 * hh + 4);
            float p[4][8];
#pragma unroll
            for (int r = 0; r < 4; ++r) { float fa[8], fb[8]; unpack8(a[r][hh], fa); unpack8(b[r][hh], fb);
#pragma unroll
                for (int i = 0; i < 8; ++i) p[r][i] = fa[i] * fb[i]; }
#pragma unroll
            for (int k = 0; k < 2; ++k) { float fc[8]; unpack8(cbv[k][hh], fc);
#pragma unroll
                for (int i = 0; i < 8; ++i) { const float w0 = i < 4 ? w0a[i & 3] : w0b[i & 3], w1 = i < 4 ? w1a[i & 3] : w1b[i & 3], w2 = i < 4 ? w2a[i & 3] : w2b[i & 3];
                    y[k][8 * hh + i] = fc[i] * (w0 * p[k][i] + w1 * p[k + 1][i] + w2 * p[k + 2][i]); } }
        }
        if (tg + NGW < T / 2) conv_loads(proj, 2 * (tg + NGW), c0, a, b, cbv);
        f32x4 g4[4];
#pragma unroll
        for (int q = 0; q < 4; ++q) g4[q] = *(const f32x4*)(cg + c0 + 4 * q);
#pragma unroll
        for (int k = 0; k < 2; ++k) {
            float ss = 0.f;
#pragma unroll
            for (int i = 0; i < 16; ++i) ss += y[k][i] * y[k][i];
            ss += __shfl_xor(ss, 1); ss += __shfl_xor(ss, 2); ss += __shfl_xor(ss, 4);
            const float rn = rsqrtf(ss * (1.0f / 128.0f) + EPS);
#pragma unroll
            for (int hh = 0; hh < 2; ++hh) { v4u o; float z[8];
#pragma unroll
                for (int i = 0; i < 8; ++i) z[i] = y[k][8 * hh + i] * rn * g4[2 * hh + (i >> 2)][i & 3];
                o.x = pkbf(z[0], z[1]); o.y = pkbf(z[2], z[3]); o.z = pkbf(z[4], z[5]); o.w = pkbf(z[6], z[7]);
                *(v4u*)(mix + (size_t)(t0 + k) * D + c0 + 8 * hh) = o; }
        }
    }
}

__device__ __forceinline__ void stage_tile(int tid, rsrc_t rsP, unsigned colbytes, LAS unsigned char* dst, const LAS float* rowscale, bool perm = false) {
    const int row0 = tid >> 5, c16 = tid & 31;
    const unsigned vo = (unsigned)(row0 * (PROJW * 2) + c16 * 16);
    LAS unsigned char* d0 = dst + row0 * TPITCH + (perm ? ((c16 >> 2) * 64 + (c16 & 3) * 8) : c16 * 16);
#pragma unroll
    for (int i = 0; i < 8; ++i) {
        v4u v = bld128(rsP, vo, colbytes + (unsigned)(i * 16 * PROJW * 2));
        if (rowscale) { float f[8]; unpack8(v, f); const float s = rowscale[row0 + 16 * i];
            v.x = pkbf(f[0] * s, f[1] * s); v.y = pkbf(f[2] * s, f[3] * s); v.z = pkbf(f[4] * s, f[5] * s); v.w = pkbf(f[6] * s, f[7] * s); }
        if (perm) { u32x2 lo, hi; lo.x = v.x; lo.y = v.y; hi.x = v.z; hi.y = v.w; *(LAS u32x2*)(d0 + i * 16 * TPITCH) = lo; *(LAS u32x2*)(d0 + i * 16 * TPITCH + 32) = hi; }
        else *(LAS v4u*)(d0 + i * 16 * TPITCH) = v;
        if (i == 3) __builtin_amdgcn_sched_barrier(0); }
}
__device__ __forceinline__ void bst128(v4u v, rsrc_t rs, unsigned voff, unsigned soff) { __builtin_amdgcn_raw_buffer_store_b128(v, rs, voff, soff, 0); }

__device__ __forceinline__ void tile_load(int tid, rsrc_t rsP, unsigned colbytes, v4u (&r)[8]) {
    const unsigned vo = (unsigned)((tid >> 5) * (PROJW * 2) + (tid & 31) * 16);
#pragma unroll
    for (int i = 0; i < 8; ++i) r[i] = bld128(rsP, vo, colbytes + (unsigned)(i * 16 * PROJW * 2));
}
__device__ __forceinline__ void tile_write(int tid, LAS unsigned char* dst, const v4u (&r)[8], const LAS float* rowscale, bool perm) {
    const int row0 = tid >> 5, c16 = tid & 31;
    LAS unsigned char* d0 = dst + row0 * TPITCH + (perm ? ((c16 >> 2) * 64 + (c16 & 3) * 8) : c16 * 16);
#pragma unroll
    for (int i = 0; i < 8; ++i) { v4u v = r[i];
        if (rowscale) { float f[8]; unpack8(v, f); const float sc = rowscale[row0 + 16 * i];
            v.x = pkbf(f[0] * sc, f[1] * sc); v.y = pkbf(f[2] * sc, f[3] * sc); v.z = pkbf(f[4] * sc, f[5] * sc); v.w = pkbf(f[6] * sc, f[7] * sc); }
        if (perm) { u32x2 lo, hi; lo.x = v.x; lo.y = v.y; hi.x = v.z; hi.y = v.w; *(LAS u32x2*)(d0 + i * 16 * TPITCH) = lo; *(LAS u32x2*)(d0 + i * 16 * TPITCH + 32) = hi; }
        else *(LAS v4u*)(d0 + i * 16 * TPITCH) = v; }
}
__device__ __forceinline__ void phase_m1(const Ctx& C) {
    const bf16* proj = (const bf16*)(C.ws + WS_PROJ); const float* gates = (const float*)(C.ws + WS_GATES);
    float* BQ = (float*)(C.ws + WS_BQ); float* BK = (float*)(C.ws + WS_BK); float* KMAX = (float*)(C.ws + WS_KMAX); float* BLAST = (float*)(C.ws + WS_BLAST); float* DN = (float*)(C.ws + WS_DN);
    bf16* S = (bf16*)(C.ws + WS_S);
    LAS unsigned char* VT = C.lds + VT_OFF; LAS unsigned char* KT = C.lds + KT_OFF; LAS float* SC = (LAS float*)(C.lds + SC_OFF);
    const int wave = C.wave;
    v4u vraw[8], kraw[8]; float ipn = 0.f, fpn = 0.f;
    if (C.bid < NCHUNK * 4) { int tid = C.tid; asm volatile("" : "+v"(tid)); const int cg = C.bid >> 2, h = C.bid & 3, t0 = cg * 128;
        const rsrc_t rsP = mkrsrc(proj + (size_t)t0 * PROJW, 128u * PROJW * 2u);
        tile_load(tid, rsP, (unsigned)((5120 + 256 * h) * 2), vraw); tile_load(tid, rsP, (unsigned)((4096 + 256 * h) * 2), kraw);
        if (tid < 256) { const float* gp = gates + (size_t)(t0 + (tid & 127)) * 16; const int dir = (tid >> 7) & 1; ipn = gp[8 * dir + h]; fpn = gp[8 * dir + 4 + h]; } }
    for (int un = C.bid; un < NCHUNK * 4; un += C.G) {
        int tid = C.tid; asm volatile("" : "+v"(tid));
        const int lane = tid & 63, fr = lane & 15, fq = lane >> 4, q4 = fr >> 2, p4 = fr & 3;
        const int cg = un >> 2, h = un & 3, t0 = cg * 128;
        const int dir = (tid >> 7) & 1, j = tid & 127;
        const float ip = ipn;
        __syncthreads();
        if (tid < 256) SC[tid] = fminf(fpn, 0.f) - log1pf(__expf(-fabsf(fpn)));
        tile_write(tid, VT, vraw, nullptr, false);
        __syncthreads();
        const float lfv = (tid < 256) ? SC[tid] : 0.f;
        float inc = lfv;
#pragma unroll
        for (int o = 1; o < 64; o <<= 1) { const float tpre = __shfl_up(inc, o); if (lane >= o) inc += tpre; }
        if (lane == 63 && wave < 4) SC[772 + wave] = inc;
        __syncthreads();
        float bqv = 0.f, bkv = -3.0e38f;
        if (tid < 256) { const float w0 = SC[772 + 2 * dir], w1 = SC[772 + 2 * dir + 1]; const float incl = inc + ((wave & 1) ? w0 : 0.f);
            bqv = dir == 0 ? incl : (w0 + w1) - incl + lfv; bkv = ip - bqv; }
        float mx = bkv;
#pragma unroll
        for (int o = 1; o < 64; o <<= 1) mx = fmaxf(mx, __shfl_xor(mx, o));
        if (lane == 0 && wave < 4) SC[768 + wave] = mx;
        __syncthreads();
        if (tid < 256) { const float kmax = fmaxf(SC[768 + 2 * dir], SC[768 + 2 * dir + 1]); SC[512 + tid] = __expf(bkv - kmax);
            BQ[(size_t)(dir * 4 + h) * T + t0 + j] = bqv; BK[(size_t)(dir * 4 + h) * T + t0 + j] = bkv;
            const int u = unit_of(dir, cg, h);
            if (j == 0) KMAX[u] = kmax;
            if ((dir == 0 && j == 127) || (dir == 1 && j == 0)) BLAST[u] = bqv; }
#pragma unroll
        for (int dd = 0; dd < 2; ++dd) {
            __syncthreads();
            tile_write(tid, KT, kraw, SC + 512 + dd * 128, true);
            __syncthreads();
            const int u = unit_of(dd, cg, h);
            if (tid < 256) { float s = 0.f; for (int r = 0; r < 128; ++r) s += bf2f(*(const LAS unsigned short*)(KT + r * TPITCH + 2 * tid));
                DN[(size_t)u * 256 + (tid & ~31) + 8 * ((tid >> 2) & 3) + 4 * ((tid >> 4) & 1) + (tid & 3)] = s; }
            if (dd == 1 && un + C.G < NCHUNK * 4) {
                const int un2 = un + C.G, cg2 = un2 >> 2, h2 = un2 & 3, t02 = cg2 * 128;
                const rsrc_t rsP2 = mkrsrc(proj + (size_t)t02 * PROJW, 128u * PROJW * 2u);
                tile_load(tid, rsP2, (unsigned)((5120 + 256 * h2) * 2), vraw); tile_load(tid, rsP2, (unsigned)((4096 + 256 * h2) * 2), kraw);
                if (tid < 256) { const float* gp = gates + (size_t)(t02 + j) * 16; ipn = gp[8 * dir + h2]; fpn = gp[8 * dir + 4 + h2]; } }
            const rsrc_t rsS = mkrsrc(S + (size_t)u * 65536, 131072u);
            const unsigned sv = (unsigned)(fr * 512 + 16 * fq);
#pragma unroll
            for (int hb = 0; hb < 2; ++hb) {
                f32x4 acc[2][8];
#pragma unroll
                for (int a = 0; a < 2; ++a)
#pragma unroll
                    for (int b = 0; b < 8; ++b) acc[a][b] = (f32x4){0.f, 0.f, 0.f, 0.f};
#pragma unroll 1
                for (int ks = 0; ks < 4; ++ks) {
                    const int rb = (32 * ks + 8 * fq + q4) * TPITCH + 8 * p4;
                    bf16x8 vf[2];
#pragma unroll
                    for (int a = 0; a < 2; ++a) { const int eo = (32 * wave + 16 * a) * 2; vf[a] = cat8(tr16(VT + rb + eo), tr16(VT + rb + 4 * TPITCH + eo)); }
#pragma unroll
                    for (int b = 0; b < 8; ++b) { const bf16x8 kf = cat8(tr16(KT + rb + 32 * (8 * hb + b)), tr16(KT + rb + 4 * TPITCH + 32 * (8 * hb + b)));
#pragma unroll
                        for (int a = 0; a < 2; ++a) acc[a][b] = __builtin_amdgcn_mfma_f32_16x16x32_bf16(kf, vf[a], acc[a][b], 0, 0, 0); }
                }
#pragma unroll
                for (int a = 0; a < 2; ++a)
#pragma unroll
                    for (int b2 = 0; b2 < 4; ++b2) { v4u w; w.x = pkbf(acc[a][2 * b2][0], acc[a][2 * b2][1]); w.y = pkbf(acc[a][2 * b2][2], acc[a][2 * b2][3]); w.z = pkbf(acc[a][2 * b2 + 1][0], acc[a][2 * b2 + 1][1]); w.w = pkbf(acc[a][2 * b2 + 1][2], acc[a][2 * b2 + 1][3]);
                        bst128(w, rsS, sv + 64u * (4 * hb + b2), (unsigned)((32 * wave + 16 * a) * 512)); }
            }
        }
    }
}

__device__ __forceinline__ void phase_m2_generic(const Ctx& C) {
    const float* KMAX = (const float*)(C.ws + WS_KMAX); const float* BLAST = (const float*)(C.ws + WS_BLAST); float* DN = (float*)(C.ws + WS_DN); float* US = (float*)(C.ws + WS_US);
    bf16* S = (bf16*)(C.ws + WS_S);
    LAS float* SC = (LAS float*)(C.lds + SC_OFF);
    int tid = C.tid; asm volatile("" : "+v"(tid));
    constexpr int N_PM = 128, N_SM = 512, N_V = 40, N_ALL = N_PM + N_SM + N_V;
    const int nmine = C.G == 256 ? (C.bid < 128 ? (C.bid < N_V ? 2 : 1) : 4) : (N_ALL - C.bid + C.G - 1) / C.G;
    for (int k = 0; k < nmine; ++k) {
        const int it = C.G == 256 ? (C.bid < 128 ? (k == 0 ? C.bid : N_PM + N_SM + C.bid) : N_PM + 4 * (C.bid - 128) + k) : C.bid + k * C.G;
        int dir, seq, h, slab;
        if (it < N_PM) { dir = it >> 6; h = (it >> 4) & 3; slab = it & 15; seq = 0; }
        else if (it < N_PM + N_SM) { const int r = it - N_PM; dir = r >> 8; seq = 1 + ((r >> 6) & 3); h = (r >> 4) & 3; slab = r & 15; }
        else { const int r = it - N_PM - N_SM; dir = r / 20; const int sh = r % 20; seq = sh >> 2; h = sh & 3; slab = 16; }
        const int c0 = seq == 0 ? 0 : 128 + 16 * (seq - 1), nc = seq == 0 ? 128 : 16;
        __syncthreads();
        if (tid < nc) { const int cg = dir == 0 ? c0 + tid : c0 + nc - 1 - tid; const int u = unit_of(dir, cg, h); SC[tid] = KMAX[u]; SC[128 + tid] = BLAST[u]; }
        __syncthreads();
        if (tid == 0) { float m = 0.f;
            for (int c = 0; c < nc; c += 8) { float kx[8], bl[8];
#pragma unroll
                for (int i = 0; i < 8; ++i) { kx[i] = SC[c + i]; bl[i] = SC[128 + c + i]; }
#pragma unroll
                for (int i = 0; i < 8; ++i) { SC[256 + c + i] = m; m = bl[i] + fmaxf(m, kx[i]); } } }
        __syncthreads();
        if (tid < nc) { const float m = SC[256 + tid], kx = SC[tid], M = fmaxf(m, kx); SC[384 + tid] = __expf(m - M); SC[512 + tid] = __expf(kx - M);
            if (slab == 16) { const int cg = dir == 0 ? c0 + tid : c0 + nc - 1 - tid; float* us = US + (size_t)unit_of(dir, cg, h) * 4; us[0] = __expf(m - M); us[1] = __expf(kx - M); us[2] = M; us[3] = 0.f; } }
        __syncthreads();
        if (slab < 16) {
            float c8[8];
#pragma unroll
            for (int j = 0; j < 8; ++j) c8[j] = 0.f;
            const size_t eoff = (size_t)slab * 4096 + tid * 8;
            const int ustep = dir == 0 ? 4 : -4;
            bf16* p = S + (size_t)unit_of(dir, dir == 0 ? c0 : c0 + nc - 1, h) * 65536 + eoff;
            v4u d[16];
#pragma unroll
            for (int i = 0; i < 16; ++i) d[i] = __builtin_nontemporal_load((const v4u*)(p + (ptrdiff_t)(i * ustep) * 65536));
            for (int cb = 0; cb < nc; cb += 16) {
                v4u dn[16];
                const bool more = cb + 16 < nc;
                if (more) {
#pragma unroll
                    for (int i = 0; i < 16; ++i) dn[i] = __builtin_nontemporal_load((const v4u*)(p + (ptrdiff_t)((16 + i) * ustep) * 65536));
                }
#pragma unroll
                for (int i = 0; i < 16; ++i) { const float a = SC[384 + cb + i], b = SC[512 + cb + i];
                    v4u w; w.x = pkbf(c8[0], c8[1]); w.y = pkbf(c8[2], c8[3]); w.z = pkbf(c8[4], c8[5]); w.w = pkbf(c8[6], c8[7]);
                    *(v4u*)(p + (ptrdiff_t)(i * ustep) * 65536) = w;
                    float f[8]; unpack8(d[i], f);
#pragma unroll
                    for (int j = 0; j < 8; ++j) c8[j] = a * c8[j] + b * f[j]; }
                if (more) {
#pragma unroll
                    for (int i = 0; i < 16; ++i) d[i] = dn[i];
                }
                p += (ptrdiff_t)(16 * ustep) * 65536;
            }
        } else if (tid < 256) {
            float nv = 0.f;
            for (int c = 0; c < nc; ++c) { const int cg = dir == 0 ? c0 + c : c0 + nc - 1 - c; float* p = DN + (size_t)unit_of(dir, cg, h) * 256 + tid; const float dv = *p; *p = nv; nv = SC[384 + c] * nv + SC[512 + c] * dv; }
        }
    }
}

__device__ __forceinline__ void m2_decode_matrix(int it, bool prompt, int& dir, int& seq, int& h, int& slab) {
    if (prompt) { dir = it >> 7; h = (it >> 5) & 3; slab = it & 31; seq = 0; }
    else { dir = it >> 9; seq = 1 + ((it >> 7) & 3); h = (it >> 5) & 3; slab = it & 31; }
}
__device__ __forceinline__ void m2_stream(bf16* S, const LAS float* tab, int dir, int seq, int h, int slab, int t256) {
    const int c0 = seq == 0 ? 0 : 128 + 16 * (seq - 1), nc = seq == 0 ? 128 : 16;
    float c8[8];
#pragma unroll
    for (int j = 0; j < 8; ++j) c8[j] = 0.f;
    const int ustep = dir == 0 ? 4 : -4;
    bf16* p = S + (size_t)unit_of(dir, dir == 0 ? c0 : c0 + nc - 1, h) * 65536 + (size_t)slab * 2048 + t256 * 8;
    v4u d[16];
#pragma unroll
    for (int i = 0; i < 16; ++i) d[i] = __builtin_nontemporal_load((const v4u*)(p + (ptrdiff_t)(i * ustep) * 65536));
    for (int cb = 0; cb < nc; cb += 16) {
        v4u dn[16]; const bool more = cb + 16 < nc;
        if (more) {
#pragma unroll
            for (int i = 0; i < 16; ++i) dn[i] = __builtin_nontemporal_load((const v4u*)(p + (ptrdiff_t)((16 + i) * ustep) * 65536));
        }
#pragma unroll
        for (int i = 0; i < 16; ++i) { const float a = tab[384 + cb + i], b = tab[512 + cb + i];
            v4u w; w.x = pkbf(c8[0], c8[1]); w.y = pkbf(c8[2], c8[3]); w.z = pkbf(c8[4], c8[5]); w.w = pkbf(c8[6], c8[7]);
            *(v4u*)(p + (ptrdiff_t)(i * ustep) * 65536) = w;
            float f[8]; unpack8(d[i], f);
#pragma unroll
            for (int j = 0; j < 8; ++j) c8[j] = a * c8[j] + b * f[j]; }
        if (more) {
#pragma unroll
            for (int i = 0; i < 16; ++i) d[i] = dn[i];
        }
        p += (ptrdiff_t)(16 * ustep) * 65536;
    }
}
__device__ __forceinline__ void phase_m2(const Ctx& C) {
    if (C.G != 256) { phase_m2_generic(C); return; }
    const float* KMAX = (const float*)(C.ws + WS_KMAX); const float* BLAST = (const float*)(C.ws + WS_BLAST); float* DN = (float*)(C.ws + WS_DN); float* US = (float*)(C.ws + WS_US);
    bf16* S = (bf16*)(C.ws + WS_S);
    LAS float* SC = (LAS float*)(C.lds + SC_OFF);
    int tid = C.tid; asm volatile("" : "+v"(tid));
    const bool has_vec = C.bid < 40;
    __syncthreads();
#pragma unroll 1
    for (int t = 0; t < 6; ++t) {
        int dir, seq, h, slab;
        if (t == 0) m2_decode_matrix(C.bid, true, dir, seq, h, slab); else if (t < 5) m2_decode_matrix(4 * C.bid + t - 1, false, dir, seq, h, slab);
        else { if (!has_vec) break; dir = C.bid / 20; const int sh = C.bid % 20; seq = sh >> 2; h = sh & 3; }
        const int c0 = seq == 0 ? 0 : 128 + 16 * (seq - 1), nc = seq == 0 ? 128 : 16;
        if (tid < nc) { const int cg = dir == 0 ? c0 + tid : c0 + nc - 1 - tid; const int u = unit_of(dir, cg, h); SC[t * 640 + tid] = KMAX[u]; SC[t * 640 + 128 + tid] = BLAST[u]; }
    }
    __syncthreads();
    if (tid < 6 && (tid < 5 || has_vec)) { LAS float* tb = SC + tid * 640; const int nc = (tid == 0 || (tid == 5 && (C.bid % 20) < 4)) ? 128 : 16; float m = 0.f;
        for (int c = 0; c < nc; c += 8) { float kx[8], bl[8];
#pragma unroll
            for (int i = 0; i < 8; ++i) { kx[i] = tb[c + i]; bl[i] = tb[128 + c + i]; }
#pragma unroll
            for (int i = 0; i < 8; ++i) { tb[256 + c + i] = m; m = bl[i] + fmaxf(m, kx[i]); } } }
    __syncthreads();
#pragma unroll 1
    for (int t = 0; t < 6; ++t) {
        if (t == 5 && !has_vec) break;
        const int nc = (t == 0 || (t == 5 && (C.bid % 20) < 4)) ? 128 : 16;
        if (tid < nc) { LAS float* tb = SC + t * 640; const float m = tb[256 + tid], kx = tb[tid], M = fmaxf(m, kx); tb[384 + tid] = __expf(m - M); tb[512 + tid] = __expf(kx - M);
            if (t == 5) { const int dir = C.bid / 20, sh = C.bid % 20, seq = sh >> 2, h = sh & 3; const int c0 = seq == 0 ? 0 : 128 + 16 * (seq - 1);
                const int cg = dir == 0 ? c0 + tid : c0 + nc - 1 - tid; float* us = US + (size_t)unit_of(dir, cg, h) * 4; us[0] = __expf(m - M); us[1] = __expf(kx - M); us[2] = M; us[3] = 0.f; } }
    }
    __syncthreads();
    if (tid < 256) { int dir, seq, h, slab; m2_decode_matrix(C.bid, true, dir, seq, h, slab); m2_stream(S, SC, dir, seq, h, slab, tid); }
    else {
        const int t2 = tid - 256;
#pragma unroll 1
        for (int k = 0; k < 4; ++k) { int dir, seq, h, slab; m2_decode_matrix(4 * C.bid + k, false, dir, seq, h, slab); m2_stream(S, SC + (1 + k) * 640, dir, seq, h, slab, t2); }
        if (has_vec) { const int dir = C.bid / 20, sh = C.bid % 20, seq = sh >> 2, h = sh & 3; const int c0 = seq == 0 ? 0 : 128 + 16 * (seq - 1), nc = seq == 0 ? 128 : 16;
            const LAS float* tb = SC + 5 * 640; float nv = 0.f;
            for (int c = 0; c < nc; ++c) { const int cg = dir == 0 ? c0 + c : c0 + nc - 1 - c; float* p = DN + (size_t)unit_of(dir, cg, h) * 256 + t2; const float dv = *p; *p = nv; nv = tb[384 + c] * nv + tb[512 + c] * dv; } }
    }
}

__device__ __forceinline__ void m3_fetch(const Ctx& C, int l, int tid, int wave, int un, v4u (&vraw)[8], v4u (&kraw)[8], float (&scn)[3]) {
    const bf16* proj = (const bf16*)(C.ws + WS_PROJ); const float* BK = (const float*)(C.ws + WS_BK); const float* KMAX = (const float*)(C.ws + WS_KMAX); const float* DN = (const float*)(C.ws + WS_DN);
    const int cg = un >> 2, h = un & 3, t0 = cg * 128; (void)wave;
    const rsrc_t rsP = mkrsrc(proj + (size_t)t0 * PROJW, 128u * PROJW * 2u);
    tile_load(tid, rsP, (unsigned)((5120 + 256 * h) * 2), vraw); tile_load(tid, rsP, (unsigned)((4096 + 256 * h) * 2), kraw);
    const int dd = tid >> 8, ix = tid & 255, ud = unit_of(dd, cg, h);
    scn[0] = DN[(size_t)ud * 256 + ix];
    scn[1] = ix < 128 ? __expf(BK[(size_t)(dd * 4 + h) * T + t0 + ix] - KMAX[ud]) : 0.f;
    scn[2] = dd == 0 ? C.mlstm_norm_g[(size_t)l * 1024 + 256 * h + ix] : 0.f;
}
__device__ __forceinline__ void phase_m3(const Ctx& C, int l, unsigned long long* tm = nullptr) {
    const bf16* proj = (const bf16*)(C.ws + WS_PROJ); bf16* mix = (bf16*)(C.ws + WS_MIX);
    const float* BQ = (const float*)(C.ws + WS_BQ);
    const float* US = (const float*)(C.ws + WS_US); const bf16* S = (const bf16*)(C.ws + WS_S);
    LAS unsigned char* VT = C.lds + VT_OFF; LAS unsigned char* KT = C.lds + KT_OFF; LAS float* SC = (LAS float*)(C.lds + SC_OFF);
    const int wave = C.wave;
    v4u vraw[8], kraw[8]; float scn[3] = {0.f, 0.f, 0.f};
    if (C.bid < NCHUNK * 4) { int tid = C.tid; asm volatile("" : "+v"(tid)); m3_fetch(C, l, tid, wave, C.bid, vraw, kraw, scn); }
    for (int un = C.bid; un < NCHUNK * 4; un += C.G) {
        int tid = C.tid; asm volatile("" : "+v"(tid));
        const int lane = tid & 63, fr = lane & 15, fq = lane >> 4, q4 = fr >> 2, p4 = fr & 3;
        const int cg = un >> 2, h = un & 3, t0 = cg * 128, tl = 16 * wave + fr, t = t0 + tl;
        const rsrc_t rsP = mkrsrc(proj + (size_t)t0 * PROJW, 128u * PROJW * 2u);
        const unsigned pv = (unsigned)(tl * (PROJW * 2));
        unsigned long long tq0 = 0ull; if (tm) tq0 = __builtin_amdgcn_s_memrealtime();
        __syncthreads();
        bf16x8 qf[8];
#pragma unroll
        for (int ks = 0; ks < 8; ++ks) qf[ks] = __builtin_bit_cast(bf16x8, bld128(rsP, pv + 16u * fq + 64u * ks, (unsigned)((3072 + 256 * h) * 2)));
        { const int dd = tid >> 8, ix = tid & 255;
          SC[256 * dd + ix] = scn[0];
          if (ix < 128) SC[512 + 128 * dd + ix] = scn[1];
          if (dd == 0) SC[768 + ix] = scn[2]; }
        tile_write(tid, VT, vraw, nullptr, true);
        tile_write(tid, KT, kraw, nullptr, false);
        bf16x8 pf[2][4]; float al[2], inv[2];
        __syncthreads();
        if (tm) { const unsigned long long t_ = __builtin_amdgcn_s_memrealtime(); tm[0] += t_ - tq0; tq0 = t_; }
#pragma unroll
        for (int dir = 0; dir < 2; ++dir) {
            const int u = unit_of(dir, cg, h);
            const float be = US[(size_t)u * 4 + 1], MM = US[(size_t)u * 4 + 2], bqt = BQ[(size_t)(dir * 4 + h) * T + t];
            al[dir] = US[(size_t)u * 4];
            const LAS float* nv = SC + 256 * dir; const LAS float* wkv = SC + 512 + 128 * dir;
            float qn = 0.f;
#pragma unroll
            for (int ks = 0; ks < 8; ++ks) {
                const f32x4 n0 = *(const LAS f32x4*)(nv + 32 * ks + 8 * fq), n1 = *(const LAS f32x4*)(nv + 32 * ks + 8 * fq + 4);
#pragma unroll
                for (int j = 0; j < 4; ++j) qn += bf2f((unsigned short)qf[ks][j]) * n0[j] + bf2f((unsigned short)qf[ks][4 + j]) * n1[j];
                __builtin_amdgcn_sched_barrier(0);
            }
            qn += __shfl_xor(qn, 16); qn += __shfl_xor(qn, 32);
            float rsum = 0.f;
            const int sp_lo = dir == 0 ? 0 : (wave >> 1), sp_hi = dir == 0 ? (wave >> 1) : 3;
#pragma unroll
            for (int sp = 0; sp < 4; ++sp) {
                v4u pw; pw.x = 0u; pw.y = 0u; pw.z = 0u; pw.w = 0u;
                if (sp >= sp_lo && sp <= sp_hi) {
                    f32x4 st0 = (f32x4){0.f, 0.f, 0.f, 0.f}, st1 = (f32x4){0.f, 0.f, 0.f, 0.f};
                    LAS const unsigned char* kb = KT + (32 * sp + fr) * TPITCH + 16 * fq;
#pragma unroll
                    for (int ks = 0; ks < 8; ++ks) { const bf16x8 k0 = *(LAS const bf16x8*)(kb + 64 * ks), k1 = *(LAS const bf16x8*)(kb + 16 * TPITCH + 64 * ks);
                        st0 = __builtin_amdgcn_mfma_f32_16x16x32_bf16(k0, qf[ks], st0, 0, 0, 0); st1 = __builtin_amdgcn_mfma_f32_16x16x32_bf16(k1, qf[ks], st1, 0, 0, 0);
                        if ((ks & 3) == 3) __builtin_amdgcn_sched_barrier(0); }
                    const f32x4 wk0 = *(const LAS f32x4*)(wkv + 32 * sp + 4 * fq) * be, wk1 = *(const LAS f32x4*)(wkv + 32 * sp + 16 + 4 * fq) * be;
                    int tlx = tl - 4 * fq; asm volatile("" : "+v"(tlx));
#pragma unroll
                    for (int jj = 0; jj < 4; ++jj) { const int s0 = 32 * sp + jj, s1 = s0 + 16;
                        const bool k0 = dir == 0 ? (s0 <= tlx) : (s0 >= tlx), k1 = dir == 0 ? (s1 <= tlx) : (s1 >= tlx);
                        st0[jj] = k0 ? st0[jj] * wk0[jj] : 0.f; st1[jj] = k1 ? st1[jj] * wk1[jj] : 0.f; rsum += st0[jj] + st1[jj]; }
                    pw.x = pkbf(st0[0], st0[1]); pw.y = pkbf(st0[2], st0[3]); pw.z = pkbf(st1[0], st1[1]); pw.w = pkbf(st1[2], st1[3]);
                }
                pf[dir][sp] = __builtin_bit_cast(bf16x8, pw);
            }
            rsum += __shfl_xor(rsum, 16); rsum += __shfl_xor(rsum, 32);
            const float den = al[dir] * qn + rsum, lower = __expf(-bqt - MM);
            inv[dir] = __builtin_amdgcn_rcpf(fmaxf(fabsf(den), lower));
        }
        __syncthreads();
        if (tm) { const unsigned long long t_ = __builtin_amdgcn_s_memrealtime(); tm[1] += t_ - tq0; tq0 = t_; }
        f32x4 hs[16];
        const int dl = lane & 31, dh = lane >> 5;
#define M3_ISSUE(sl) do { const bf16* src_ = S + (size_t)unit_of((sl) & 1, cg, h) * 65536 + (size_t)(64 * ((sl) >> 1)) * 256; \
            _Pragma("unroll") for (int i_ = 0; i_ < 4; ++i_) { const int row_ = 2 * (4 * wave + i_) + dh; \
                const int erow_ = 32 * (row_ >> 5) + 8 * ((row_ & 15) >> 2) + 4 * ((row_ >> 4) & 1) + (row_ & 3);     \
                __builtin_amdgcn_global_load_lds((const unsigned*)(src_ + (size_t)erow_ * 256 + ((dl ^ (row_ & 15)) * 8)), (LAS unsigned*)(KT + ((sl) & 1) * 32768 + (4 * wave + i_) * 1024), 16, 0, 0); } } while (0)
        M3_ISSUE(0);
#pragma unroll
        for (int sl = 0; sl < 8; ++sl) {
            const int qt = sl >> 1, dir = sl & 1;
            asm volatile("s_waitcnt vmcnt(0)" ::: "memory"); __builtin_amdgcn_s_barrier(); asm volatile("" ::: "memory");
            if (sl + 1 < 8) M3_ISSUE(sl + 1);
            const int sp_lo = dir == 0 ? 0 : (wave >> 1), sp_hi = dir == 0 ? (wave >> 1) : 3;
            LAS const unsigned char* cb = KT + (sl & 1) * 32768 + fr * 512;
            f32x4 acc[4];
#pragma unroll
            for (int e4 = 0; e4 < 4; ++e4) acc[e4] = (f32x4){0.f, 0.f, 0.f, 0.f};
#pragma unroll
            for (int ks = 0; ks < 8; ++ks) {
                const int ch = ((4 * ks + fq) ^ fr) * 16;
#pragma unroll
                for (int e4 = 0; e4 < 4; ++e4) { const bf16x8 cf = *(LAS const bf16x8*)(cb + e4 * 8192 + ch); acc[e4] = __builtin_amdgcn_mfma_f32_16x16x32_bf16(cf, qf[ks], acc[e4], 0, 0, 0); }
            }
#pragma unroll
            for (int e4 = 0; e4 < 4; ++e4) acc[e4] = acc[e4] * al[dir];
#pragma unroll
            for (int sp = 0; sp < 4; ++sp) {
                if (sp >= sp_lo && sp <= sp_hi) {
                    LAS const unsigned char* vb = VT + (32 * sp + 4 * fq + q4) * TPITCH + 8 * p4 + 32 * 4 * qt;
#pragma unroll
                    for (int e4 = 0; e4 < 4; ++e4) { const bf16x8 vf = cat8(tr16(vb + 32 * e4), tr16(vb + 16 * TPITCH + 32 * e4)); acc[e4] = __builtin_amdgcn_mfma_f32_16x16x32_bf16(vf, pf[dir][sp], acc[e4], 0, 0, 0); }
                }
            }
#pragma unroll
            for (int e4 = 0; e4 < 4; ++e4) { if (dir == 0) hs[4 * qt + e4] = acc[e4] * inv[0]; else hs[4 * qt + e4] += acc[e4] * inv[1]; }
        }
#undef M3_ISSUE
        if (tm) { const unsigned long long t_ = __builtin_amdgcn_s_memrealtime(); tm[2] += t_ - tq0; tq0 = t_; }
        v4u owv[8];
#pragma unroll
        for (int i = 0; i < 8; ++i) owv[i] = bld128(rsP, pv + 16u * fq + 64u * i, (unsigned)((6144 + 256 * h) * 2));
        float ss = 0.f;
#pragma unroll
        for (int eb = 0; eb < 16; ++eb) ss += (hs[eb][0] * hs[eb][0] + hs[eb][1] * hs[eb][1]) + (hs[eb][2] * hs[eb][2] + hs[eb][3] * hs[eb][3]);
        ss += __shfl_xor(ss, 16); ss += __shfl_xor(ss, 32);
        const float rn = rsqrtf(ss * (1.0f / 256.0f) + EPS);
        v4u yk[8];
#pragma unroll
        for (int i = 0; i < 8; ++i) { const f32x4 ga = *(const LAS f32x4*)(SC + 768 + 32 * i + 8 * fq), gb = *(const LAS f32x4*)(SC + 768 + 32 * i + 8 * fq + 4);
            float o[8]; unpack8(owv[i], o); float y[8];
#pragma unroll
            for (int j = 0; j < 4; ++j) { y[j] = hs[2 * i][j] * rn * ga[j] * __builtin_amdgcn_rcpf(1.0f + __expf(-o[j])); y[4 + j] = hs[2 * i + 1][j] * rn * gb[j] * __builtin_amdgcn_rcpf(1.0f + __expf(-o[4 + j])); }
            yk[i].x = pkbf(y[0], y[1]); yk[i].y = pkbf(y[2], y[3]); yk[i].z = pkbf(y[4], y[5]); yk[i].w = pkbf(y[6], y[7]); }
        asm volatile("" ::: "memory");
        { int tf = C.tid; asm volatile("" : "+v"(tf));
          m3_fetch(C, l, tf, wave, (un + C.G < NCHUNK * 4) ? un + C.G : un, vraw, kraw, scn); }
        const rsrc_t rsM = mkrsrc(mix + (size_t)t0 * D, 128u * D * 2u);
#pragma unroll
        for (int i = 0; i < 8; ++i) bst128(yk[i], rsM, (unsigned)(tl * (D * 2)) + 16u * fq + 64u * i, (unsigned)((1024 + 256 * h) * 2));
        if (tm) { const unsigned long long t_ = __builtin_amdgcn_s_memrealtime(); tm[3] += t_ - tq0; }
    }
}

__device__ __forceinline__ void glufix_row(const Ctx& C, int l, int tid_, int row, const float* hm, const float* h0, const float* hp) {
    const float* fw = C.ffn_conv_w + (size_t)l * 3 * NUP; const float* fb = C.ffn_conv_b + (size_t)l * NUP; bf16* act = (bf16*)(C.ws + WS_ACT);
    for (int f = 4 * tid_; f < DFF; f += 4 * 512) {
        const f32x4 w0g = *(const f32x4*)(fw + f), w1g = *(const f32x4*)(fw + NUP + f), w2g = *(const f32x4*)(fw + 2 * NUP + f), bg = *(const f32x4*)(fb + f);
        const f32x4 w0v = *(const f32x4*)(fw + DFF + f), w1v = *(const f32x4*)(fw + NUP + DFF + f), w2v = *(const f32x4*)(fw + 2 * NUP + DFF + f), bv = *(const f32x4*)(fb + DFF + f);
        const f32x4 ag = *(const f32x4*)(hm + f), av = *(const f32x4*)(hm + DFF + f), bgv = *(const f32x4*)(h0 + f), bvv = *(const f32x4*)(h0 + DFF + f), cg4 = *(const f32x4*)(hp + f), cv4 = *(const f32x4*)(hp + DFF + f);
        float z[4];
#pragma unroll
        for (int j = 0; j < 4; ++j) { const float g = bg[j] + w0g[j] * ag[j] + w1g[j] * bgv[j] + w2g[j] * cg4[j], vv = bv[j] + w0v[j] * av[j] + w1v[j] * bvv[j] + w2v[j] * cv4[j];
            z[j] = g * __builtin_amdgcn_rcpf(1.0f + __expf(-g)) * vv; }
        u32x2 w; w.x = pkbf(z[0], z[1]); w.y = pkbf(z[2], z[3]);
        *(u32x2*)(act + (size_t)row * DFF + f) = w;
    }
}
__device__ __forceinline__ bool seq_start_panel(int pm) { return pm == 0 || pm == 64 || (pm > 64 && ((pm - 64) & 7) == 0); }
__device__ __forceinline__ void glufix_panel(const Ctx& C, int l, int tid_, int pm) {
    const float* HB = (const float*)(C.ws + WS_HB);
    if (!seq_start_panel(pm)) glufix_row(C, l, tid_, 256 * pm, HB + (size_t)((pm - 1) * 4 + 3) * NUP, HB + (size_t)(pm * 4 + 0) * NUP, HB + (size_t)(pm * 4 + 1) * NUP);
    if (pm + 1 < 96 && !seq_start_panel(pm + 1)) glufix_row(C, l, tid_, 256 * pm + 255, HB + (size_t)(pm * 4 + 2) * NUP, HB + (size_t)(pm * 4 + 3) * NUP, HB + (size_t)((pm + 1) * 4 + 0) * NUP);
}

__device__ __forceinline__ void phase_final(const Ctx& C) {
    int tid_ = C.tid; asm volatile("" : "+v"(tid_)); const int lane_ = tid_ & 63;
    const int gw = C.bid * 8 + C.wave, NGW = C.G * 8;
    const bf16* xl = (const bf16*)(C.ws + WS_X); const bf16* xh = (const bf16*)(C.ws + WS_XB);
    const f32x4* g4 = (const f32x4*)C.final_norm_g + lane_;
    u32x2 a[8], b[8];
    if (gw < T) { const u32x2* h2 = (const u32x2*)(xh + (size_t)gw * D) + lane_; const u32x2* l2 = (const u32x2*)(xl + (size_t)gw * D) + lane_;
#pragma unroll
        for (int j = 0; j < 8; ++j) { a[j] = h2[64 * j]; if (MK_RESID_LO) b[j] = l2[64 * j]; else { b[j].x = 0u; b[j].y = 0u; } } }
    for (int r = gw; r < T; r += NGW) {
        u32x2 an[8], bn[8]; const int rn = r + NGW;
        if (rn < T) { const u32x2* h2 = (const u32x2*)(xh + (size_t)rn * D) + lane_; const u32x2* l2 = (const u32x2*)(xl + (size_t)rn * D) + lane_;
#pragma unroll
            for (int j = 0; j < 8; ++j) { an[j] = h2[64 * j]; if (MK_RESID_LO) bn[j] = l2[64 * j]; else { bn[j].x = 0u; bn[j].y = 0u; } } }
        f32x4* d4 = (f32x4*)(C.out + (size_t)r * D) + lane_;
        f32x4 v[8]; float ss = 0.f;
#pragma unroll
        for (int j = 0; j < 8; ++j) {
            v[j][0] = __uint_as_float(a[j].x << 16) + __uint_as_float(b[j].x << 16); v[j][1] = __uint_as_float(a[j].x & 0xffff0000u) + __uint_as_float(b[j].x & 0xffff0000u);
            v[j][2] = __uint_as_float(a[j].y << 16) + __uint_as_float(b[j].y << 16); v[j][3] = __uint_as_float(a[j].y & 0xffff0000u) + __uint_as_float(b[j].y & 0xffff0000u);
            ss += (v[j][0] * v[j][0] + v[j][1] * v[j][1]) + (v[j][2] * v[j][2] + v[j][3] * v[j][3]); }
        const float rs = rsqrtf(wave_sum(ss) * (1.0f / 2048.0f) + EPS);
#pragma unroll
        for (int j = 0; j < 8; ++j) d4[64 * j] = v[j] * rs * g4[64 * j];
        if (rn < T) {
#pragma unroll
            for (int j = 0; j < 8; ++j) { a[j] = an[j]; b[j] = bn[j]; } }
    }
}

template <class Sched> __device__ __forceinline__ pg8::RsTab rs_table_fill(const Ctx& C, const Sched& S, const float* ps) {
    pg8::RsTab rt; rt.tab = (LAS const float*)(C.lds + RST_OFF); rt.pm0 = rt.pm1 = rt.pm2 = rt.pm3 = -1; rt.ps = ps;
    pg8::Unit uu;
    for (int i = 0; S.next(i, uu); ++i) { const int p = uu.pm;
        if (p == rt.pm0 || p == rt.pm1 || p == rt.pm2 || p == rt.pm3) continue;
        if (rt.pm0 < 0) rt.pm0 = p; else if (rt.pm1 < 0) rt.pm1 = p; else if (rt.pm2 < 0) rt.pm2 = p; else if (rt.pm3 < 0) rt.pm3 = p; }
    int tid_ = C.tid; asm volatile("" : "+v"(tid_));
    LAS float* tab = (LAS float*)(C.lds + RST_OFF);
    if (tid_ < 256) {
        if (rt.pm0 >= 0) tab[tid_] = pg8::rstd_of_row(ps + (size_t)(rt.pm0 * 256 + tid_) * 32);
        if (rt.pm1 >= 0) tab[256 + tid_] = pg8::rstd_of_row(ps + (size_t)(rt.pm1 * 256 + tid_) * 32);
        if (rt.pm2 >= 0) tab[512 + tid_] = pg8::rstd_of_row(ps + (size_t)(rt.pm2 * 256 + tid_) * 32);
        if (rt.pm3 >= 0) tab[768 + tid_] = pg8::rstd_of_row(ps + (size_t)(rt.pm3 * 256 + tid_) * 32);
    }
    __syncthreads();
    return rt;
}

#ifndef MK_STAG
#define MK_STAG 0
#endif
__device__ __forceinline__ void stagger(const Ctx& C, unsigned ticks) {
    if (!MK_STAG) return;
    const unsigned g = (unsigned)C.bid & 3u;
    if (g) { const unsigned long long t0 = __builtin_amdgcn_s_memrealtime(); while (__builtin_amdgcn_s_memrealtime() - t0 < (unsigned long long)(g * ticks)) __builtin_amdgcn_s_sleep(4); }
}

constexpr int N_PHASES = 30;
#ifndef MK_REP_X0
#define MK_REP_X0 0
#endif
#ifndef MK_REP_FIN
#define MK_REP_FIN 0
#endif
#ifndef MK_TIME_PHASE
#define MK_TIME_PHASE -1
#endif
#ifndef MK_REP_V1
#define MK_REP_V1 0
#endif
#ifndef MK_REP_V4
#define MK_REP_V4 0
#endif
#ifndef MK_XBAR
#define MK_XBAR 0
#endif
#ifndef MK_ONE_LAUNCH
#define MK_ONE_LAUNCH 1
#endif
struct Args { const float* in[15]; float* out; unsigned char* ws; int ph_lo, ph_hi, use_bar, pad; };
__global__ void __launch_bounds__(512, 2) mk_fwd(Args args) {
    extern __shared__ __attribute__((aligned(16))) unsigned char lds[];
    Ctx C;
    C.lds = (LAS unsigned char*)lds; C.tid = threadIdx.x; C.lane = C.tid & 63; C.wave = __builtin_amdgcn_readfirstlane(C.tid >> 6); C.G = gridDim.x; C.bid = blockIdx.x;
    C.x_prompt = args.in[0]; C.x_sample = args.in[1]; C.norm_mix_g = args.in[2]; C.w_in = args.in[3]; C.gate_b = args.in[4]; C.conv_w = args.in[5]; C.conv_norm_g = args.in[6]; C.mlstm_norm_g = args.in[7];
    C.w_out = args.in[8]; C.norm_ffn_g = args.in[9]; C.w_up = args.in[10]; C.ffn_conv_w = args.in[11]; C.ffn_conv_b = args.in[12]; C.w_down = args.in[13]; C.final_norm_g = args.in[14];
    C.out = args.out; C.ws = args.ws;
    volatile LAS unsigned* MISC = (volatile LAS unsigned*)(C.lds + MISC_OFF);
    if (C.tid < 64) MISC[C.tid] = 0u;
    __syncthreads();
    unsigned* barw = (unsigned*)(C.ws + WS_CTL) + CW_BAR;
    XcdBarrier bar; bar.bar = barw; bar.x = 0; bar.st = nullptr;
    if (args.use_bar) bar = xcd_barrier_post(barw, MISC + 8);
    const int lo = args.ph_lo, hi = args.ph_hi;
#define IN(k) (lo <= (k) && (k) < hi)
    unsigned long long tacc = 0ull, tph0 = 0ull; unsigned long long tm3[4] = {0ull, 0ull, 0ull, 0ull}; unsigned long long tim1[3] = {0ull, 0ull, 0ull}, tim5[3] = {0ull, 0ull, 0ull}, tim4[3] = {0ull, 0ull, 0ull}, tim7[3] = {0ull, 0ull, 0ull};
#define TBEG(k) do { if (MK_TIME_PHASE == (k)) tph0 = __builtin_amdgcn_s_memrealtime(); } while (0)
#define TEND(k) do { if (MK_TIME_PHASE == (k)) tacc += __builtin_amdgcn_s_memrealtime() - tph0; } while (0)
#define SEAM(k) do { if (IN((k) + 1)) xcd_barrier(bar); } while (0)
    float* SS = (float*)(C.ws + WS_PS);
    bf16* XB = (bf16*)(C.ws + WS_XB);
    if (IN(0)) { for (int rep = 0; rep <= 4 * MK_REP_X0; ++rep) phase_x0(C); phase_w(C, 0); SEAM(0); }
#pragma unroll 1
    for (int l = 0; l < DEPTH; ++l) {
        const int pb = 1 + 7 * l;
        const unsigned char* W = C.ws + WS_W + (size_t)(l & 1) * W_BUF;
        if (IN(pb + 0)) { TBEG(0);
            pg8::Gemm g{XB, (const bf16*)(W + WO_IN), T, NINP, D}; pg8::StaticOrder S; S.init(T, NINP, C.G, C.bid);
            pg8::EpiProj E{(bf16*)(C.ws + WS_PROJ), (float*)(C.ws + WS_GATES), rs_table_fill(C, S, SS + (size_t)(2 * l) * T * 32), C.gate_b + l * 16};
            pg8::gemm_phase<pg8::EpiProj, pg8::StaticOrder, true, true>(C.lds, g, S, E, (MK_TIME_PHASE == 10 || MK_TIME_PHASE == 11) ? tim1 : nullptr);
            SEAM(pb + 0); TEND(0);
        }
        if (IN(pb + 1)) { TBEG(1); TBEG(40); phase_m1(C); __syncthreads(); TEND(40); TBEG(41); if (l + 1 < DEPTH) phase_w(C, l + 1, C.G == 256 ? 2 : 0); TEND(41); SEAM(pb + 1); TEND(1); }
        if (IN(pb + 2)) { TBEG(2); TBEG(30); TBEG(31); phase_m2(C); TEND(30); TEND(31); TBEG(32); phase_conv(C, l, 0, C.G); TEND(32); SEAM(pb + 2); TEND(2); }
        if (IN(pb + 3)) { TBEG(3); phase_m3(C, l, (MK_TIME_PHASE >= 50 && MK_TIME_PHASE <= 53) ? tm3 : nullptr); for (int xb_ = 0; xb_ < MK_XBAR; ++xb_) xcd_barrier(bar); SEAM(pb + 3); TEND(3); }
        if (IN(pb + 4)) { TBEG(4);
            pg8::Gemm g{(const bf16*)(C.ws + WS_MIX), (const bf16*)(W + WO_OUT), T, D, D}; pg8::StaticOrder S; S.init(T, D, C.G, C.bid);
            pg8::EpiResid E{XB, (bf16*)(C.ws + WS_X), SS + (size_t)(2 * l + 1) * T * 32, 1.f, 1, MK_RESID_LO != 0, MK_RESID_LO == 1};
            pg8::gemm_phase<pg8::EpiResid, pg8::StaticOrder, true, true>(C.lds, g, S, E, (MK_TIME_PHASE == 14 || MK_TIME_PHASE == 15) ? tim4 : nullptr);
            SEAM(pb + 4); TEND(4);
        }
        if (IN(pb + 5)) { TBEG(5);
            pg8::Gemm g{XB, (const bf16*)(W + WO_UP), T, NUP, D}; pg8::StaticOrder S; S.init(T, NUP, C.G, C.bid);
            pg8::EpiGlu E{(bf16*)(C.ws + WS_ACT), (float*)(C.ws + WS_HB), rs_table_fill(C, S, SS + (size_t)(2 * l + 1) * T * 32), C.ffn_conv_w + (size_t)l * 3 * NUP, C.ffn_conv_b + (size_t)l * NUP, C.lds + HALO_OFF};
            pg8::gemm_phase<pg8::EpiGlu, pg8::StaticOrder, true, true>(C.lds, g, S, E, (MK_TIME_PHASE == 12 || MK_TIME_PHASE == 13) ? tim5 : nullptr);
            if (l + 1 < DEPTH && C.G == 256) phase_w(C, l + 1, 1);
            SEAM(pb + 5); TEND(5);
        }
        if (IN(pb + 6)) { TBEG(6);
            pg8::Gemm g{(const bf16*)(C.ws + WS_ACT), (const bf16*)(W + WO_DOWN), T, D, DFF}; pg8::StaticOrder S; S.init(T, D, C.G, C.bid);
            { int tid_ = C.tid; asm volatile("" : "+v"(tid_)); pg8::Unit uu; int last_pm = -1;
              for (int i = 0; S.next(i, uu); ++i) { if (uu.pm != last_pm) glufix_panel(C, l, tid_, uu.pm); last_pm = uu.pm; }
              asm volatile("s_waitcnt vmcnt(0)" ::: "memory"); __syncthreads(); }
            pg8::EpiResid E{XB, (bf16*)(C.ws + WS_X), SS + (size_t)(2 * l + 2) * T * 32, 1.f, 1, MK_RESID_LO == 1, MK_RESID_LO != 0};
            pg8::gemm_phase<pg8::EpiResid, pg8::StaticOrder, true, true>(C.lds, g, S, E, (MK_TIME_PHASE == 16 || MK_TIME_PHASE == 17) ? tim7 : nullptr);
            SEAM(pb + 6); TEND(6);
        }
    }
    if (IN(29)) { for (int rep = 0; rep <= 4 * MK_REP_FIN; ++rep) phase_final(C); }
    if (MK_TIME_PHASE == 10) tacc = tim1[1]; if (MK_TIME_PHASE == 11) tacc = tim1[0]; if (MK_TIME_PHASE == 12) tacc = tim5[1]; if (MK_TIME_PHASE == 13) tacc = tim5[0]; if (MK_TIME_PHASE >= 50 && MK_TIME_PHASE <= 53) tacc = tm3[MK_TIME_PHASE - 50]; if (MK_TIME_PHASE == 14) tacc = tim4[1]; if (MK_TIME_PHASE == 15) tacc = tim4[0]; if (MK_TIME_PHASE == 16) tacc = tim7[1]; if (MK_TIME_PHASE == 17) tacc = tim7[0];
    if (MK_TIME_PHASE == 20) { const unsigned xcc = xb_xcc_id(); if (xcc != (blockIdx.x & 7u)) { const unsigned long long t0 = __builtin_amdgcn_s_memrealtime(); while (__builtin_amdgcn_s_memrealtime() - t0 < 100000ull) __builtin_amdgcn_s_sleep(8); } }
    if (MK_TIME_PHASE >= 0 && MK_TIME_PHASE != 20 && blockIdx.x == ((MK_TIME_PHASE == 31 || MK_TIME_PHASE == 32) ? 255u : 0u)) { const unsigned long long t0 = __builtin_amdgcn_s_memrealtime(); while (__builtin_amdgcn_s_memrealtime() - t0 < tacc) __builtin_amdgcn_s_sleep(8); }
#undef IN
#undef SEAM
}

extern "C" void kernel_launch(void* const* d_in, const int* in_sizes, int n_in, void* d_out, int out_size, void* d_ws, size_t ws_size, hipStream_t stream) {
    static int grid = 0;
    if (grid == 0) {
        if (n_in != 15 || out_size != T * D || ws_size < WS_END) { fprintf(stderr, "kernel_launch: unexpected shapes (n_in %d, out %d, ws %zu < %zu); nothing launched\n", n_in, out_size, ws_size, (size_t)WS_END); grid = -1; return; }
        int dev = 0, cus = 0, per_cu = 0;
        if (hipGetDevice(&dev) != hipSuccess || hipDeviceGetAttribute(&cus, hipDeviceAttributeMultiprocessorCount, dev) != hipSuccess) { grid = -1; return; }
        if (hipFuncSetAttribute((const void*)mk_fwd, hipFuncAttributeMaxDynamicSharedMemorySize, LDS_BYTES) != hipSuccess) { fprintf(stderr, "kernel_launch: hipFuncSetAttribute failed\n"); grid = -1; return; }
        if (hipOccupancyMaxActiveBlocksPerMultiprocessor(&per_cu, (const void*)mk_fwd, 512, LDS_BYTES) != hipSuccess || per_cu < 1) { fprintf(stderr, "kernel_launch: occupancy query says %d blocks per CU\n", per_cu); }
        (void)hipGetLastError();
        grid = cus;
    }
    if (grid < 0) return;
    (void)hipMemsetAsync((char*)d_ws + WS_CTL, 0, CTL_ZERO_BYTES, stream);
    Args a{};
    for (int i = 0; i < 15; ++i) a.in[i] = (const float*)d_in[i];
    a.out = (float*)d_out; a.ws = (unsigned char*)d_ws;
#if MK_ONE_LAUNCH
    a.ph_lo = 0; a.ph_hi = N_PHASES; a.use_bar = 1;
    hipLaunchKernelGGL(mk_fwd, dim3(grid), dim3(512), LDS_BYTES, stream, a);
#else
    for (int p = 0; p < N_PHASES; ++p) { a.ph_lo = p; a.ph_hi = p + 1; a.use_bar = 0; hipLaunchKernelGGL(mk_fwd, dim3(grid), dim3(512), LDS_BYTES, stream, a); }
#endif
}
```

```cpp
#include <hip/hip_runtime.h>
#include <cstdio>
#include <cstdint>
namespace pg8 {
#define PG8_LAS __attribute__((address_space(3)))
typedef unsigned short bf16_t;
typedef short bf16x8 __attribute__((ext_vector_type(8)));
typedef float f32x4 __attribute__((ext_vector_type(4)));
typedef unsigned u32x4 __attribute__((ext_vector_type(4)));
constexpr int BM = 256, BK = 64, HALF = 128, HTB = HALF * BK * 2  , STAGE_BYTES = 8 * HTB, NXCD = 8, WGM = 8;

__host__ __device__ __forceinline__ int lds_byte(int r, int c) { const int st = (r >> 4) * 2 + (c >> 5), rr = r & 15, cc = c & 31, ob = rr * 64 + cc * 2; return st * 1024 + (ob ^ (((ob >> 9) & 1) << 5)); }
__host__ __device__ __forceinline__ void stage_rc(int b, int& R, int& C) { const int st = b / 1024, sb = b % 1024, swz = sb ^ (((sb >> 9) & 1) << 5); R = (st >> 1) * 16 + swz / 64; C = (st & 1) * 32 + (swz % 64) / 2; }
__host__ __device__ __forceinline__ int perm32(int rho) { const int n = rho >> 4, i = rho & 15; return 8 * (i >> 2) + 4 * n + (i & 3); }

struct Unit { int pm, pn; };
struct Gemm { const bf16_t* A; const bf16_t* Bt; int M, N, K; };

struct StaticOrder {
    int nM, nN, nwg, G, c, wgm;
    __host__ __device__ __forceinline__ void init(int M, int N, int G_, int c_, int wgm_ = WGM) { nM = M / BM; nN = N / BM; nwg = nM * nN; G = G_; c = c_; wgm = wgm_; }
    __host__ __device__ __forceinline__ bool next(int i, Unit& u) const {
        const long L = (long)i * G + c; if (L >= nwg) return false;
        int wgid = (int)L; { const int q = nwg / NXCD, r = nwg % NXCD, xcd = wgid % NXCD, off = wgid / NXCD; wgid = (xcd < r ? xcd * (q + 1) : r * (q + 1) + (xcd - r) * q) + off; }
        const int nig = wgm * nN, gid = wgid / nig, fm = gid * wgm, gsz = (nM - fm) < wgm ? (nM - fm) : wgm;
        u.pm = fm + ((wgid % nig) % gsz); u.pn = (wgid % nig) / gsz; return true;
    }
    __device__ __forceinline__ void a_ready(const Unit&) const {}
    __device__ __forceinline__ void done(const Unit&) const {}
};

__device__ __forceinline__ unsigned cvt_pk_bf16(float lo, float hi) { unsigned r; asm volatile("v_cvt_pk_bf16_f32 %0, %1, %2" : "=v"(r) : "v"(lo), "v"(hi)); return r; }
typedef float f32x2 __attribute__((ext_vector_type(2)));
typedef unsigned u32x2 __attribute__((ext_vector_type(2)));
typedef float f32x2 __attribute__((ext_vector_type(2)));
constexpr float RMS_EPS = 1e-6f;
__device__ __forceinline__ float rstd_of_row(const float* p) {
    f32x4 s = *(const f32x4*)p;
#pragma unroll
    for (int i = 1; i < 8; ++i) s += *(const f32x4*)(p + 4 * i);
    return rsqrtf(((s[0] + s[1]) + (s[2] + s[3])) * (1.0f / 2048.0f) + RMS_EPS);
}
struct RsTab { PG8_LAS const float* tab; int pm0, pm1, pm2, pm3; const float* ps;
    __device__ __forceinline__ int slot(int pm) const { return pm == pm0 ? 0 : pm == pm1 ? 1 : pm == pm2 ? 2 : pm == pm3 ? 3 : -1; }
    __device__ __forceinline__ void get8(int pm, int wr, int fr, float (&rs)[2][4]) const { const int sl = slot(pm);
        if (sl >= 0) { PG8_LAS const float* t = tab + sl * 256 + wr * 64 + fr;
#pragma unroll
            for (int ai = 0; ai < 2; ++ai)
#pragma unroll
                for (int m = 0; m < 4; ++m) rs[ai][m] = t[ai * HALF + m * 16]; }
        else { const float* q = ps + (size_t)(pm * BM + wr * 64 + fr) * 32;
#pragma unroll
            for (int ai = 0; ai < 2; ++ai)
#pragma unroll
                for (int m = 0; m < 4; ++m) rs[ai][m] = rstd_of_row(q + (size_t)(ai * HALF + m * 16) * 32); } }
    __device__ __forceinline__ void get8p(int pm, int wr, int fr, float (&rs)[2][4]) const { const int sl = slot(pm);
        if (sl >= 0) { PG8_LAS const float* t = tab + sl * 256 + wr * 64 + 4 * fr;
#pragma unroll
            for (int ai = 0; ai < 2; ++ai) { const f32x4 v = *(PG8_LAS const f32x4*)(t + ai * HALF); rs[ai][0] = v[0]; rs[ai][1] = v[1]; rs[ai][2] = v[2]; rs[ai][3] = v[3]; } }
        else { const float* q = ps + (size_t)(pm * BM + wr * 64 + 4 * fr) * 32;
#pragma unroll
            for (int ai = 0; ai < 2; ++ai)
#pragma unroll
                for (int m = 0; m < 4; ++m) rs[ai][m] = rstd_of_row(q + (size_t)(ai * HALF + m) * 32); } } };
#ifndef MK_KV_PLAIN
#define MK_KV_PLAIN 1
#endif
struct EpiProj {
    static constexpr int PERM = 3, APERM = 0; static constexpr bool AFTER_DRAIN = false, PREFETCH = false;
    bf16_t* P; float* gates; RsTab rt; const float* gate_b;
    __device__ __forceinline__ void operator()(const f32x4 (&acc)[2][2][4][2], const Unit& u, int wr, int wc, int fr, int fq) const {
        const int row0 = u.pm * BM + wr * 64 + fr; float rs8[2][4]; rt.get8(u.pm, wr, fr, rs8);
        if (u.pn >= 4 && u.pn < 12) {
            const int col0 = 1024 + (u.pn - 4) * 128 + wc * 32 + 8 * fq;
#pragma unroll
            for (int ai = 0; ai < 2; ++ai)
#pragma unroll
                for (int m = 0; m < 4; ++m) { const int r = row0 + ai * HALF + m * 16; const float rs2 = rs8[ai][m] * rs8[ai][m];
                    const f32x4 v0 = acc[ai][0][m][0] * acc[ai][1][m][0] * rs2, v1 = acc[ai][0][m][1] * acc[ai][1][m][1] * rs2;
                    u32x4 w; w.x = cvt_pk_bf16(v0[0], v0[1]); w.y = cvt_pk_bf16(v0[2], v0[3]); w.z = cvt_pk_bf16(v1[0], v1[1]); w.w = cvt_pk_bf16(v1[2], v1[3]);
                    __builtin_nontemporal_store(w, (u32x4*)(P + (size_t)r * 6144 + col0)); }
        } else if (u.pn < 28) {
            const int col0 = (u.pn < 4 ? u.pn * BM : u.pn * BM - 1024) + wc * 64 + 8 * fq;
#pragma unroll
            for (int ai = 0; ai < 2; ++ai)
#pragma unroll
                for (int m = 0; m < 4; ++m) { const int r = row0 + ai * HALF + m * 16; const float rs = rs8[ai][m];
                    bf16_t* rowp = P + (size_t)r * 6144 + col0;
#pragma unroll
                    for (int bj = 0; bj < 2; ++bj) { const f32x4 v0 = acc[ai][bj][m][0] * rs, v1 = acc[ai][bj][m][1] * rs;
                        u32x4 w; w.x = cvt_pk_bf16(v0[0], v0[1]); w.y = cvt_pk_bf16(v0[2], v0[3]); w.z = cvt_pk_bf16(v1[0], v1[1]); w.w = cvt_pk_bf16(v1[2], v1[3]);
                        if (MK_KV_PLAIN && u.pn >= 16 && u.pn < 24) *(u32x4*)(rowp + bj * 32) = w; else __builtin_nontemporal_store(w, (u32x4*)(rowp + bj * 32)); } }
        } else if (wc == 0 && fq < 2) {
#pragma unroll
            for (int ai = 0; ai < 2; ++ai)
#pragma unroll
                for (int m = 0; m < 4; ++m) { const int r = row0 + ai * HALF + m * 16; const float rs = rs8[ai][m];
                    float* gp = gates + (size_t)r * 16 + 8 * fq;
#pragma unroll
                    for (int n = 0; n < 2; ++n) *(f32x4*)(gp + 4 * n) = acc[ai][0][m][n] * rs + *(const f32x4*)(gate_b + 8 * fq + 4 * n); }
        }
    }
};
#ifndef MK_LO8
#define MK_LO8 1
#endif
#ifndef MK_RESID_LO
#define MK_RESID_LO 2
#endif
struct EpiResid {
    static constexpr int PERM = 3, APERM = 0; static constexpr bool AFTER_DRAIN = false, PREFETCH = false;
    bf16_t* xh; bf16_t* xl; float* ps; float sign; int do_ss; int rd_lo, wr_lo; const float* xf0; const float* xf1;
    __device__ __forceinline__ void operator()(const f32x4 (&acc)[2][2][4][2], const Unit& u, int wr, int wc, int fr, int fq) const {
        const int row0 = u.pm * BM + wr * 64 + fr, col0 = u.pn * BM + wc * 64 + 8 * fq;
        const float* xfb = u.pm < 64 ? xf0 : xf1 - (size_t)16384 * 2048;
#pragma unroll
        for (int ai = 0; ai < 2; ++ai) {
            u32x4 vh[4][2], vl[4][2];
#pragma unroll
            for (int m = 0; m < 4; ++m)
#pragma unroll
                for (int bj = 0; bj < 2; ++bj) { const size_t o = (size_t)(row0 + ai * HALF + m * 16) * 2048 + col0 + bj * 32;
                    if (xf0) { const float* xr = xfb + o; vh[m][bj] = *(const u32x4*)xr; vl[m][bj] = *(const u32x4*)(xr + 4); }
                    else { vh[m][bj] = *(const u32x4*)(xh + o);
#if MK_LO8
                        vl[m][bj] = (u32x4){0u, 0u, 0u, 0u}; if (rd_lo) { const u32x2 t8 = *(const u32x2*)((const unsigned char*)xl + o); vl[m][bj].x = t8.x; vl[m][bj].y = t8.y; } } }
#else
                        if (rd_lo) vl[m][bj] = *(const u32x4*)(xl + o); else vl[m][bj] = (u32x4){0u, 0u, 0u, 0u}; } }
#endif
#pragma unroll
            for (int m = 0; m < 4; ++m) { const int r = row0 + ai * HALF + m * 16; const size_t off = (size_t)r * 2048 + col0; float ss = 0.f;
#pragma unroll
                for (int bj = 0; bj < 2; ++bj) { const u32x4 h4 = vh[m][bj], l4 = vl[m][bj]; u32x4 wh, wl;
#pragma unroll
                    for (int n = 0; n < 2; ++n) { const unsigned hx = n ? h4.z : h4.x, hy = n ? h4.w : h4.y, lx = n ? l4.z : l4.x, ly = n ? l4.w : l4.y;
                        f32x4 v;
                        v[0] = __uint_as_float(hx << 16) + __uint_as_float(lx << 16); v[1] = __uint_as_float(hx & 0xffff0000u) + __uint_as_float(lx & 0xffff0000u);
                        v[2] = __uint_as_float(hy << 16) + __uint_as_float(ly << 16); v[3] = __uint_as_float(hy & 0xffff0000u) + __uint_as_float(ly & 0xffff0000u);
#if MK_LO8
                        { const int lw = (int)(n ? l4.y : l4.x); const f32x2 a01 = __builtin_amdgcn_cvt_pk_f32_fp8(lw, false), a23 = __builtin_amdgcn_cvt_pk_f32_fp8(lw, true);
                          v[0] = __uint_as_float(hx << 16) + a01.x * (1.0f / 512.0f); v[1] = __uint_as_float(hx & 0xffff0000u) + a01.y * (1.0f / 512.0f);
                          v[2] = __uint_as_float(hy << 16) + a23.x * (1.0f / 512.0f); v[3] = __uint_as_float(hy & 0xffff0000u) + a23.y * (1.0f / 512.0f); }
#endif
                        if (xf0) { const u32x4 f4 = n ? l4 : h4; v[0] = __uint_as_float(f4.x); v[1] = __uint_as_float(f4.y); v[2] = __uint_as_float(f4.z); v[3] = __uint_as_float(f4.w); }
                        v = v + acc[ai][bj][m][n] * sign;
                        ss += (v[0] * v[0] + v[1] * v[1]) + (v[2] * v[2] + v[3] * v[3]);
                        const unsigned w0 = cvt_pk_bf16(v[0], v[1]), w1 = cvt_pk_bf16(v[2], v[3]);
                        const unsigned q0 = cvt_pk_bf16(v[0] - __uint_as_float(w0 << 16), v[1] - __uint_as_float(w0 & 0xffff0000u)), q1 = cvt_pk_bf16(v[2] - __uint_as_float(w1 << 16), v[3] - __uint_as_float(w1 & 0xffff0000u));
#if MK_LO8
#define ER_Q8(val_, hi_) __builtin_amdgcn_fmed3f(((val_) - (hi_)) * 512.0f, -448.0f, 448.0f)
                        int p8 = __builtin_amdgcn_cvt_pk_fp8_f32(ER_Q8(v[0], __uint_as_float(w0 << 16)), ER_Q8(v[1], __uint_as_float(w0 & 0xffff0000u)), 0, false);
                        p8 = __builtin_amdgcn_cvt_pk_fp8_f32(ER_Q8(v[2], __uint_as_float(w1 << 16)), ER_Q8(v[3], __uint_as_float(w1 & 0xffff0000u)), p8, true);
#undef ER_Q8
                        (void)q0; (void)q1;
                        if (n == 0) { wh.x = w0; wh.y = w1; wl.x = (unsigned)p8; } else { wh.z = w0; wh.w = w1; wl.y = (unsigned)p8; } }
                    *(u32x4*)(xh + off + bj * 32) = wh;
                    if (wr_lo) { u32x2 t8; t8.x = wl.x; t8.y = wl.y; *(u32x2*)((unsigned char*)xl + off + bj * 32) = t8; } }
#else
                        if (n == 0) { wh.x = w0; wh.y = w1; wl.x = q0; wl.y = q1; } else { wh.z = w0; wh.w = w1; wl.z = q0; wl.w = q1; } }
                    *(u32x4*)(xh + off + bj * 32) = wh;
                    if (wr_lo) *(u32x4*)(xl + off + bj * 32) = wl; }
#endif
                ss += __shfl_xor(ss, 16); ss += __shfl_xor(ss, 32);
                if (fq == 0 && do_ss) ps[(size_t)r * 32 + u.pn * 4 + wc] = ss; }
            asm volatile("" ::: "memory");
        }
    }
};
__device__ __forceinline__ float dpp_shr1(float old, float src) { return __builtin_bit_cast(float, __builtin_amdgcn_update_dpp(__builtin_bit_cast(int, old), __builtin_bit_cast(int, src), 0x111, 0xf, 0xf, false)); }
__device__ __forceinline__ float dpp_shl1(float old, float src) { return __builtin_bit_cast(float, __builtin_amdgcn_update_dpp(__builtin_bit_cast(int, old), __builtin_bit_cast(int, src), 0x101, 0xf, 0xf, false)); }
__device__ __forceinline__ float dpp_ror1(float src) { return __builtin_bit_cast(float, __builtin_amdgcn_mov_dpp(__builtin_bit_cast(int, src), 0x121, 0xf, 0xf, true)); }
__device__ __forceinline__ float dpp_rol1(float src) { return __builtin_bit_cast(float, __builtin_amdgcn_mov_dpp(__builtin_bit_cast(int, src), 0x12F, 0xf, 0xf, true)); }
struct EpiGlu {
    static constexpr int PERM = 1, APERM = 1; static constexpr bool AFTER_DRAIN = false, PREFETCH = true;
    __device__ __forceinline__ void prefetch(const Unit& u, int wr, int wc, int lane) const {
        const int v = lane >> 3, c4 = (lane & 7) * 4;
        const float* src = ((v & 3) == 3 ? cb : cw + (v & 3) * NUP_) + (v >> 2) * DFF_ + u.pn * 128 + wc * 32 + c4;
        __builtin_amdgcn_global_load_lds((const unsigned*)src, (PG8_LAS unsigned*)(hl + 8192 + (wr * 4 + wc) * 1024), 16, 0, 0);
    }
    static constexpr int DFF_ = 5632, NUP_ = 11264;
    bf16_t* act; float* HB; RsTab rt; const float* cw; const float* cb; PG8_LAS unsigned char* hl;
    __device__ __forceinline__ void operator()(const f32x4 (&acc)[2][2][4][2], const Unit& u, int wr, int wc, int fr, int fq) const {
        const int row0 = u.pm * BM + wr * 64 + 4 * fr, cl = wc * 32 + 8 * fq;
        float rs[2][4]; rt.get8p(u.pm, wr, fr, rs);
        PG8_LAS const float* wl = (PG8_LAS const float*)(hl + 8192 + (wr * 4 + wc) * 1024);
        if (fr == 0 || fr == 15) {
#pragma unroll
            for (int ai = 0; ai < 2; ++ai) { const int slot = 2 * (2 * ai + wr) + (fr == 15 ? 1 : 0); const float rsv = fr == 15 ? rs[ai][3] : rs[ai][0];
#pragma unroll
                for (int bj = 0; bj < 2; ++bj)
#pragma unroll
                    for (int n = 0; n < 2; ++n) { const f32x4 a0 = fr == 15 ? acc[ai][bj][3][n] : acc[ai][bj][0][n];
                        *(PG8_LAS f32x4*)(hl + slot * 1024 + (bj * 128 + cl + 4 * n) * 4) = a0 * rsv; } }
        }
        if ((wr == 0 && fr == 0) || (wr == 1 && fr == 15)) {
#pragma unroll
            for (int q = 0; q < 2; ++q) {
                float* hb = HB + (size_t)(u.pm * 4 + 2 * wr + q) * NUP_ + u.pn * 128 + cl; const float rsv = wr ? rs[1][2 + q] : rs[0][q];
#pragma unroll
                for (int bj = 0; bj < 2; ++bj)
#pragma unroll
                    for (int n = 0; n < 2; ++n) { const f32x4 a0 = wr ? acc[1][bj][2 + q][n] : acc[0][bj][q][n]; *(f32x4*)(hb + bj * DFF_ + 4 * n) = a0 * rsv; } }
        }
        asm volatile("s_waitcnt lgkmcnt(0)" ::: "memory"); __builtin_amdgcn_s_barrier(); asm volatile("" ::: "memory");
        u32x2 keep[2][4];
#pragma unroll
        for (int n = 0; n < 2; ++n) {
            PG8_LAS const float* wp = wl + 8 * fq + 4 * n;
            const f32x4 w0g = *(PG8_LAS const f32x4*)wp, w1g = *(PG8_LAS const f32x4*)(wp + 32), w2g = *(PG8_LAS const f32x4*)(wp + 64), bg = *(PG8_LAS const f32x4*)(wp + 96);
            const f32x4 w0v = *(PG8_LAS const f32x4*)(wp + 128), w1v = *(PG8_LAS const f32x4*)(wp + 160), w2v = *(PG8_LAS const f32x4*)(wp + 192), bv = *(PG8_LAS const f32x4*)(wp + 224);
#pragma unroll
            for (int ai = 0; ai < 2; ++ai) {
                const int sg = 2 * ai + wr;
                f32x4 Ug[4], Uv[4];
#pragma unroll
                for (int m = 0; m < 4; ++m) { Ug[m] = acc[ai][0][m][n] * rs[ai][m]; Uv[m] = acc[ai][1][m][n] * rs[ai][m]; }
                f32x4 hug = (f32x4){0.f, 0.f, 0.f, 0.f}, huv = hug, hdg = hug, hdv = hug;
                if (sg > 0) { PG8_LAS const unsigned char* p = hl + (2 * (sg - 1) + 1) * 1024 + (cl + 4 * n) * 4; hug = *(PG8_LAS const f32x4*)p; huv = *(PG8_LAS const f32x4*)(p + 512); }
                if (sg < 3) { PG8_LAS const unsigned char* p = hl + (2 * (sg + 1)) * 1024 + (cl + 4 * n) * 4;     hdg = *(PG8_LAS const f32x4*)p; hdv = *(PG8_LAS const f32x4*)(p + 512); }
                f32x4 upg, upv, dng, dnv;
#pragma unroll
                for (int j = 0; j < 4; ++j) { upg[j] = dpp_shr1(hug[j], Ug[3][j]); upv[j] = dpp_shr1(huv[j], Uv[3][j]); dng[j] = dpp_shl1(hdg[j], Ug[0][j]); dnv[j] = dpp_shl1(hdv[j], Uv[0][j]); }
#pragma unroll
                for (int m = 0; m < 4; ++m) {
                    const f32x4 ag = m > 0 ? Ug[m - 1] : upg, av = m > 0 ? Uv[m - 1] : upv, cg = m < 3 ? Ug[m + 1] : dng, cv = m < 3 ? Uv[m + 1] : dnv;
                    u32x2 w;
#pragma unroll
                    for (int h = 0; h < 2; ++h) {
#define EG_H2(v) (h ? __builtin_shufflevector(v, v, 2, 3) : __builtin_shufflevector(v, v, 0, 1))
                        const f32x2 g = EG_H2(bg) + EG_H2(w0g) * EG_H2(ag) + EG_H2(w1g) * EG_H2(Ug[m]) + EG_H2(w2g) * EG_H2(cg), vv = EG_H2(bv) + EG_H2(w0v) * EG_H2(av) + EG_H2(w1v) * EG_H2(Uv[m]) + EG_H2(w2v) * EG_H2(cv);
#undef EG_H2
                        const f32x2 t = g * -1.44269504088896340736f;
                        f32x2 e; e.x = __builtin_amdgcn_exp2f(t.x); e.y = __builtin_amdgcn_exp2f(t.y);
                        const f32x2 d = e + 1.0f;
                        f32x2 r; r.x = __builtin_amdgcn_rcpf(d.x); r.y = __builtin_amdgcn_rcpf(d.y);
                        const f32x2 z = g * r * vv;
                        if (h) w.y = cvt_pk_bf16(z.x, z.y); else w.x = cvt_pk_bf16(z.x, z.y);
                    }
                    if (n == 0) keep[ai][m] = w;
                    else { u32x4 o; o.x = keep[ai][m].x; o.y = keep[ai][m].y; o.z = w.x; o.w = w.y; __builtin_nontemporal_store(o, (u32x4*)(act + (size_t)(row0 + ai * HALF + m) * DFF_ + u.pn * 128 + cl)); }
                }
            }
        }
    }
};
template <class Epi, class Sched, bool ALIGN_EPI = false, bool SP2 = false>
__device__ __forceinline__ void gemm_phase(PG8_LAS unsigned char* lds, const Gemm g, const Sched& S, const Epi& E, unsigned long long* tim = nullptr) {
    int tid = threadIdx.x; asm volatile("" : "+v"(tid));
    const int wid = __builtin_amdgcn_readfirstlane(tid >> 6), lane = tid & 63, wr = wid >> 2, wc = wid & 3, fr = lane & 15, fq = lane >> 4;
    const int K = g.K, nt = K / BK;
    unsigned voffA[2], voffB[2];
#pragma unroll
    for (int i = 0; i < 2; ++i) { int R, C; stage_rc(tid * 16 + i * 8192, R, C);
        const int Rb = (int)Epi::PERM == 3 ? (64 * (R >> 5) + 8 * ((R & 15) >> 2) + 4 * ((R >> 4) & 1) + (R & 3)) : (int)Epi::PERM == 2 ? (64 * (R >> 5) + 16 * ((R & 15) >> 2) + 4 * ((R >> 4) & 1) + (R & 3)) : ((int)Epi::PERM == 1 ? ((R & ~31) + perm32(R & 31)) : R);
        const int Ra = (int)Epi::APERM ? ((R & ~63) + 4 * (R & 15) + ((R >> 4) & 3)) : R;
        voffA[i] = (unsigned)(Ra * K + C) * 2u; voffB[i] = (unsigned)(Rb * K + C) * 2u; }
    const size_t kstep = (size_t)(BK * 2);
    const size_t hstep = (size_t)HALF * K * 2;
    const size_t hstepB = (int)Epi::PERM == 3 ? (size_t)32 * K * 2 : (int)Epi::PERM == 2 ? (size_t)8 * K * 2 : hstep;
    const size_t tstep = 2 * hstep;
    const unsigned ldsw = (unsigned)wid * 1024u;
    const int aoff = lds_byte(wr * 64 + fr, fq * 8), boff = lds_byte(wc * 32 + fr, fq * 8);
#define PG8_SA(b, h) (((b) * 2 + (h)) * HTB)
#define PG8_SB(b, h) ((4 + (b) * 2 + (h)) * HTB)
#define PG8_STAGE(bufoff, gbase, voff) do { _Pragma("unroll") for (int _i = 0; _i < 2; ++_i) \
        __builtin_amdgcn_global_load_lds((const unsigned*)((const char*)(gbase) + (voff)[_i]), (PG8_LAS unsigned*)(lds + (bufoff) + ldsw + _i * 8192), 16, 0, 0); } while (0)
#define PG8_LDA(dst, b, h) do { _Pragma("unroll") for (int m = 0; m < 4; ++m) _Pragma("unroll") for (int k = 0; k < 2; ++k) dst[m][k] = *(const PG8_LAS bf16x8*)(lds + PG8_SA(b, h) + aoff + m * 2048 + k * 1024); } while (0)
#define PG8_LDB(dst, b, h) do { _Pragma("unroll") for (int n = 0; n < 2; ++n) _Pragma("unroll") for (int k = 0; k < 2; ++k) dst[n][k] = *(const PG8_LAS bf16x8*)(lds + PG8_SB(b, h) + boff + n * 2048 + k * 1024); } while (0)
#define PG8_MMA(ai, bj, At, Bt) do { __builtin_amdgcn_s_setprio(1); _Pragma("unroll") for (int m = 0; m < 4; ++m) _Pragma("unroll") for (int n = 0; n < 2; ++n) _Pragma("unroll") for (int k = 0; k < 2; ++k) \
        acc[ai][bj][m][n] = __builtin_amdgcn_mfma_f32_16x16x32_bf16(Bt[n][k], At[m][k], acc[ai][bj][m][n], 0, 0, 0); __builtin_amdgcn_s_setprio(0); } while (0)
#define PG8_WAIT_V(n) asm volatile("s_waitcnt vmcnt(" #n ")" ::: "memory")
#define PG8_WAIT_L(n) asm volatile("s_waitcnt lgkmcnt(" #n ")" ::: "memory")
#define PG8_BAR __builtin_amdgcn_s_barrier()
#define PG8_SCHED __builtin_amdgcn_sched_barrier(0)
    Unit cur, nxt; int ui = 0;
    if (!S.next(0, cur)) return;
    f32x4 acc[2][2][4][2];
#pragma unroll
    for (int a = 0; a < 2; ++a)
#pragma unroll
        for (int b = 0; b < 2; ++b)
#pragma unroll
            for (int m = 0; m < 4; ++m)
#pragma unroll
                for (int n = 0; n < 2; ++n) acc[a][b][m][n] = (f32x4){0.f, 0.f, 0.f, 0.f};
    bf16x8 At[4][2], B0[2][2], B1[2][2];
    const char* cA = (const char*)g.A + (size_t)cur.pm * tstep; const char* cB = (const char*)g.Bt + (size_t)cur.pn * tstep;
    S.a_ready(cur);
    if constexpr (Epi::PREFETCH) E.prefetch(cur, wr, wc, lane);
    if constexpr (SP2) {
        PG8_STAGE(PG8_SB(0, 0), cB, voffB); PG8_STAGE(PG8_SB(0, 1), cB + hstepB, voffB); PG8_STAGE(PG8_SA(0, 0), cA, voffA); PG8_STAGE(PG8_SA(0, 1), cA + hstep, voffA);
        if (wr == 1) PG8_BAR;
        PG8_WAIT_V(2); PG8_BAR;
        PG8_STAGE(PG8_SB(1, 0), cB + kstep, voffB); PG8_STAGE(PG8_SA(1, 0), cA + kstep, voffA); PG8_STAGE(PG8_SB(1, 1), cB + hstepB + kstep, voffB);
        PG8_WAIT_V(6); PG8_BAR;
    } else {
        PG8_STAGE(PG8_SB(0, 0), cB, voffB); PG8_STAGE(PG8_SA(0, 0), cA, voffA); PG8_STAGE(PG8_SB(0, 1), cB + hstepB, voffB); PG8_STAGE(PG8_SA(0, 1), cA + hstep, voffA);
        if (wr == 1) PG8_BAR;
        PG8_WAIT_V(4); PG8_BAR;
        PG8_STAGE(PG8_SB(1, 0), cB + kstep, voffB); PG8_STAGE(PG8_SA(1, 0), cA + kstep, voffA); PG8_STAGE(PG8_SB(1, 1), cB + hstepB + kstep, voffB);
        PG8_WAIT_V(6); PG8_BAR;
    }
    if (tim) { tim[2] = __builtin_amdgcn_s_memrealtime(); asm volatile("s_waitcnt lgkmcnt(0)" ::: "memory"); }
    for (;;) {
        const bool has_next = S.next(ui + 1, nxt);
        const char* nA = has_next ? (const char*)g.A + (size_t)nxt.pm * tstep : cA; const char* nB = has_next ? (const char*)g.Bt + (size_t)nxt.pn * tstep : cB;
        for (int t = 0; t < nt; t += 2) {
            const bool last = (t == nt - 2);
            const char* a1 = cA + (size_t)(t + 1) * kstep;
            const char* a2 = last ? nA : cA + (size_t)(t + 2) * kstep; const char* b2 = last ? nB : cB + (size_t)(t + 2) * kstep;
            const char* a3 = a2 + kstep; const char* b3 = b2 + kstep;
            if (last && has_next) S.a_ready(nxt);
            if constexpr (SP2) {
            PG8_LDB(B0, 0, 0); PG8_LDB(B1, 0, 1); PG8_SCHED; PG8_LDA(At, 0, 0); PG8_STAGE(PG8_SA(1, 1), a1 + hstep, voffA);
            PG8_WAIT_V(8); PG8_WAIT_L(0); PG8_BAR; PG8_MMA(0, 0, At, B0); PG8_MMA(0, 1, At, B1); PG8_BAR; PG8_SCHED;
            PG8_LDA(At, 0, 1); PG8_STAGE(PG8_SB(0, 0), b2, voffB); PG8_STAGE(PG8_SB(0, 1), b2 + hstepB, voffB); PG8_STAGE(PG8_SA(0, 0), a2, voffA);
            PG8_WAIT_V(8); PG8_WAIT_L(0); PG8_BAR; PG8_MMA(1, 0, At, B0); PG8_MMA(1, 1, At, B1); PG8_BAR; PG8_SCHED;
            PG8_LDB(B0, 1, 0); PG8_LDB(B1, 1, 1); PG8_SCHED; PG8_LDA(At, 1, 0); PG8_STAGE(PG8_SA(0, 1), a2 + hstep, voffA);
            PG8_WAIT_V(8); PG8_WAIT_L(0); PG8_BAR; PG8_MMA(0, 0, At, B0); PG8_MMA(0, 1, At, B1); PG8_BAR; PG8_SCHED;
            PG8_LDA(At, 1, 1); PG8_STAGE(PG8_SB(1, 0), b3, voffB); PG8_STAGE(PG8_SB(1, 1), b3 + hstepB, voffB); PG8_STAGE(PG8_SA(1, 0), a3, voffA);
            PG8_WAIT_V(8); PG8_WAIT_L(0); PG8_BAR; PG8_MMA(1, 0, At, B0); PG8_MMA(1, 1, At, B1); PG8_BAR; PG8_SCHED;
            } else {
            PG8_LDB(B0, 0, 0); PG8_SCHED; PG8_LDA(At, 0, 0); PG8_STAGE(PG8_SA(1, 1), a1 + hstep, voffA);
            PG8_WAIT_L(8); PG8_BAR; PG8_WAIT_L(0); PG8_MMA(0, 0, At, B0); PG8_BAR; PG8_SCHED;
            PG8_LDB(B1, 0, 1); PG8_STAGE(PG8_SB(0, 0), b2, voffB);
            PG8_BAR; PG8_WAIT_L(0); PG8_MMA(0, 1, At, B1); PG8_BAR;
            PG8_LDA(At, 0, 1); PG8_STAGE(PG8_SA(0, 0), a2, voffA);
            PG8_BAR; PG8_WAIT_L(0); PG8_MMA(1, 0, At, B0); PG8_BAR; PG8_SCHED;
            PG8_STAGE(PG8_SB(0, 1), b2 + hstepB, voffB);
            PG8_WAIT_V(6); PG8_BAR; PG8_MMA(1, 1, At, B1); PG8_BAR;
            PG8_LDB(B0, 1, 0); PG8_SCHED; PG8_LDA(At, 1, 0); PG8_STAGE(PG8_SA(0, 1), a2 + hstep, voffA);
            PG8_WAIT_L(8); PG8_BAR; PG8_WAIT_L(0); PG8_MMA(0, 0, At, B0); PG8_BAR; PG8_SCHED;
            PG8_LDB(B1, 1, 1); PG8_STAGE(PG8_SB(1, 0), b3, voffB);
            PG8_BAR; PG8_WAIT_L(0); PG8_MMA(0, 1, At, B1); PG8_BAR;
            PG8_LDA(At, 1, 1); PG8_STAGE(PG8_SA(1, 0), a3, voffA);
            PG8_BAR; PG8_WAIT_L(0); PG8_MMA(1, 0, At, B0); PG8_BAR; PG8_SCHED;
            PG8_STAGE(PG8_SB(1, 1), b3 + hstepB, voffB);
            PG8_WAIT_V(6); PG8_BAR; PG8_MMA(1, 1, At, B1); PG8_BAR;
            }
        }
        if constexpr (ALIGN_EPI) { if (wr == 0) PG8_BAR; }
        unsigned long long ts_ = 0ull; if (tim) { ts_ = __builtin_amdgcn_s_memrealtime(); asm volatile("s_waitcnt lgkmcnt(0)" ::: "memory"); tim[0] += ts_ - tim[2]; }
        if constexpr (!Epi::AFTER_DRAIN) { E(acc, cur, wr, wc, fr, fq); S.done(cur); }
        if (tim) { const unsigned long long te_ = __builtin_amdgcn_s_memrealtime(); asm volatile("s_waitcnt lgkmcnt(0)" ::: "memory"); tim[1] += te_ - ts_; tim[2] = te_; }
        if (!has_next) break;
#pragma unroll
        for (int a = 0; a < 2; ++a)
#pragma unroll
            for (int b = 0; b < 2; ++b)
#pragma unroll
                for (int m = 0; m < 4; ++m)
#pragma unroll
                    for (int n = 0; n < 2; ++n) acc[a][b][m][n] = (f32x4){0.f, 0.f, 0.f, 0.f};
        cur = nxt; cA = nA; cB = nB; ++ui;
        if constexpr (Epi::PREFETCH) E.prefetch(cur, wr, wc, lane);
        if constexpr (ALIGN_EPI) { if (wr == 1) PG8_BAR; }
    }
    PG8_WAIT_V(0);
    if constexpr (!ALIGN_EPI) { if (wr == 0) PG8_BAR; }
    PG8_BAR;
    if constexpr (Epi::AFTER_DRAIN) { E.fused(acc, cur, wr, wc, fr, fq, lds, wid, lane); S.done(cur); }
#undef PG8_SA
#undef PG8_SB
#undef PG8_STAGE
#undef PG8_LDA
#undef PG8_LDB
#undef PG8_MMA
#undef PG8_WAIT_V
#undef PG8_WAIT_L
#undef PG8_BAR
#undef PG8_SCHED
}
}
#define GAS __attribute__((address_space(1)))
#define LAS __attribute__((address_space(3)))
typedef unsigned short bf16;
typedef unsigned v4u __attribute__((ext_vector_type(4)));
typedef float f32x4 __attribute__((ext_vector_type(4)));
typedef short bf16x8 __attribute__((ext_vector_type(8)));
typedef GAS unsigned gu32;
typedef GAS unsigned long long gu64;
#define RLX_AGENT __ATOMIC_RELAXED, __HIP_MEMORY_SCOPE_AGENT
#define LDS_WAIT() asm volatile("s_waitcnt lgkmcnt(0)" ::: "memory")
#define VM_WAIT() asm volatile("s_waitcnt vmcnt(0)" ::: "memory")
__device__ __forceinline__ unsigned long long rt() { return __builtin_amdgcn_s_memrealtime(); }
__device__ __forceinline__ unsigned f2bf(float f) { unsigned u = __builtin_bit_cast(unsigned, f); return (u + 0x7fffu + ((u >> 16) & 1u)) >> 16; }
__device__ __forceinline__ unsigned pk2(float lo, float hi) { return f2bf(lo) | (f2bf(hi) << 16); }

#define XB_TMO      128
#define XB_XCNT(j)  (256  + 64 * (j))
#define XB_XSUB(j)  (1280 + 64 * (j))
#define XB_XGEN(j)  (2304 + 64 * (j))
#define XB_TOP      3328
#define XB_TOPGEN   3392
#define XCD_BAR_WORDS 3456
#define XB_SPIN_CAP (1u << 18)

__device__ __forceinline__ unsigned xb_ld(unsigned* p)              { return __hip_atomic_load(p, __ATOMIC_RELAXED, __HIP_MEMORY_SCOPE_AGENT); }
__device__ __forceinline__ unsigned xb_add(unsigned* p, unsigned v) { return __hip_atomic_fetch_add(p, v, __ATOMIC_RELAXED, __HIP_MEMORY_SCOPE_AGENT); }
__device__ __forceinline__ unsigned xb_xcc_id() { return (unsigned)__builtin_amdgcn_s_getreg((3 << 11) | 20) & 0xFu; }
#define XB_SPIN(cond, bar) do { unsigned _sp = 0; while (cond) { __builtin_amdgcn_s_sleep(1); \
    if ((++_sp & 255u) == 0u) { if (xb_ld(&(bar)[XB_TMO])) break; if (_sp > XB_SPIN_CAP) { atomicAdd(&(bar)[XB_TMO], 1u); break; } } } } while (0)

struct XcdBarrier {
    unsigned* bar; unsigned x;
    volatile LAS unsigned* st;
};

__device__ __forceinline__ XcdBarrier xcd_barrier_post(unsigned* bar, volatile LAS unsigned* st) {
    XcdBarrier b; b.bar = bar; b.x = xb_xcc_id(); b.st = st;
    if (threadIdx.x == 0) (void)xb_add(&bar[XB_XCNT(b.x)], 1u);
    return b;
}
__device__ __forceinline__ void xcd_barrier_complete(unsigned* bar, unsigned x, unsigned& nloc, unsigned& nx) {
    const unsigned G = gridDim.x * gridDim.y * gridDim.z;
    unsigned sum, cnt, mine, sp = 0u;
    for (;;) {
        sum = 0u; cnt = 0u; mine = 0u;
#pragma unroll
        for (unsigned j = 0; j < 16; ++j) { const unsigned c = xb_ld(&bar[XB_XCNT(j)]); sum += c; cnt += (c > 0u) ? 1u : 0u; mine = (j == x) ? c : mine; }
        if (sum == G) break;
        __builtin_amdgcn_s_sleep(1);
        if ((++sp & 255u) == 0u) { if (xb_ld(&bar[XB_TMO])) break; if (sp > XB_SPIN_CAP) { atomicAdd(&bar[XB_TMO], 1u); break; } }
    }
    nloc = mine > 0u ? mine : 1u; nx = cnt > 0u ? cnt : 1u;
}

__device__ __forceinline__ void xcd_barrier(const XcdBarrier& b) {
    asm volatile("s_waitcnt vmcnt(0)" ::: "memory");
    __syncthreads();
    if (threadIdx.x == 0) {
        unsigned* bar = b.bar;
        __builtin_amdgcn_s_waitcnt(0);
        unsigned nloc = b.st[0], nx = b.st[1];
        if (nloc == 0u) { xcd_barrier_complete(bar, b.x, nloc, nx); b.st[0] = nloc; b.st[1] = nx; }
        const unsigned old = xb_add(&bar[XB_XSUB(b.x)], 1u);
        const unsigned gen = old / nloc;
        if (old + 1u == (gen + 1u) * nloc) {
            __builtin_amdgcn_fence(__ATOMIC_RELEASE, "agent");
            asm volatile("s_waitcnt vmcnt(0)" ::: "memory");
            const unsigned og = xb_add(&bar[XB_TOP], 1u);
            const unsigned tg = og / nx;
            if (og + 1u == (tg + 1u) * nx) xb_add(&bar[XB_TOPGEN], 1u);
            else XB_SPIN(xb_ld(&bar[XB_TOPGEN]) == tg, bar);
            __builtin_amdgcn_fence(__ATOMIC_ACQUIRE, "agent");
            xb_add(&bar[XB_XGEN(b.x)], 1u);
            asm volatile("s_waitcnt vmcnt(0)" ::: "memory");
        } else {
            XB_SPIN(xb_ld(&bar[XB_XGEN(b.x)]) == gen, bar);
            __builtin_amdgcn_fence(__ATOMIC_ACQUIRE, "agent");
            asm volatile("s_waitcnt vmcnt(0)" ::: "memory");
        }
    }
    __syncthreads();
}
constexpr int T = 24576, D = 2048, DEPTH = 4, NIN = 7184, NINP = 7424, PROJW = 6144, DFF = 5632, NUP = 11264;
constexpr int COL_P = 1024, COL_Q = 2048, COL_K = 3072, COL_V = 4096, COL_O = 5120;
constexpr int NCHUNK = 192;
constexpr float EPS = 1e-6f;
constexpr size_t MiB = 1u << 20;
constexpr size_t WS_CTL = 0, CTL_ZERO_BYTES = 1 * MiB;
constexpr size_t WS_W = 3 * MiB, W_BUF = 103 * MiB;
constexpr size_t WO_IN = 0, WO_OUT = (size_t)NINP * D * 2, WO_UP = WO_OUT + (size_t)D * D * 2, WO_DOWN = WO_UP + (size_t)NUP * D * 2;
constexpr size_t WS_X = 209 * MiB;
constexpr size_t WS_XB = 401 * MiB;
constexpr size_t WS_PROJ = 497 * MiB;
constexpr size_t WS_S = 833 * MiB;
constexpr size_t WS_MIX = 1025 * MiB;
constexpr size_t WS_ACT = 1025 * MiB;
constexpr size_t WS_SM = 1289 * MiB;
constexpr size_t WS_GATES = WS_SM, WS_BQ = WS_SM + 2 * MiB, WS_BK = WS_SM + 3 * MiB, WS_KMAX = WS_SM + 4 * MiB, WS_BLAST = WS_KMAX + 8192, WS_US = WS_KMAX + 16384, WS_DN = WS_SM + 5 * MiB;
constexpr size_t WS_HB = 1297 * MiB;
constexpr size_t WS_PS = 1315 * MiB;
constexpr size_t WS_END = 1344 * MiB;
static_assert(WO_DOWN + (size_t)D * DFF * 2 <= W_BUF && WS_W + 2 * W_BUF <= WS_X && WS_PS + (size_t)9 * T * 32 * 4 <= WS_END && WS_X + (size_t)T * D * 4 <= WS_XB && WS_XB + (size_t)T * D * 2 <= WS_PROJ, "ws map 1");
static_assert(WS_PROJ + (size_t)T * PROJW * 2 <= WS_S && WS_S + (size_t)1536 * 65536 * 2 <= WS_MIX && WS_ACT + (size_t)T * DFF * 2 <= WS_SM && WS_SM + 8 * MiB <= WS_HB && WS_HB + (size_t)96 * 4 * NUP * 4 <= WS_END, "ws map 2");
constexpr int CW_BAR = 4096;
constexpr int LDS_BYTES = 152576, MISC_OFF = LDS_BYTES - 256, HALO_OFF = 131072, RST_OFF = 147456;
constexpr int TPITCH = 528;
constexpr int VT_OFF = 0, KT_OFF = 128 * TPITCH, SC_OFF = 2 * 128 * TPITCH;
static_assert(SC_OFF + 4096 <= MISC_OFF, "lds map");

typedef short bf16x8 __attribute__((ext_vector_type(8)));
typedef short s16x4 __attribute__((ext_vector_type(4)));
typedef unsigned u32x2 __attribute__((ext_vector_type(2)));
__device__ __forceinline__ float bf2f(unsigned short b) { return __uint_as_float(((unsigned)b) << 16); }
__device__ __forceinline__ unsigned pkbf(float lo, float hi) { return pg8::cvt_pk_bf16(lo, hi); }
__device__ __forceinline__ float wave_sum(float v) {
#pragma unroll
    for (int o = 1; o < 64; o <<= 1) v += __shfl_xor(v, o);
    return v;
}
__device__ __forceinline__ s16x4 tr16(LAS const unsigned char* p) { typedef short v4i16_t __attribute__((ext_vector_type(4))); return __builtin_bit_cast(s16x4, __builtin_amdgcn_ds_read_tr16_b64_v4i16((LAS v4i16_t*)p)); }
__device__ __forceinline__ bf16x8 cat8(s16x4 a, s16x4 b) { bf16x8 r; r[0] = a[0]; r[1] = a[1]; r[2] = a[2]; r[3] = a[3]; r[4] = b[0]; r[5] = b[1]; r[6] = b[2]; r[7] = b[3]; return r; }
typedef __amdgpu_buffer_rsrc_t rsrc_t;
__device__ __forceinline__ rsrc_t mkrsrc(const void* base, unsigned nbytes) {
    const unsigned long long b = (unsigned long long)base; const unsigned lo = __builtin_amdgcn_readfirstlane((unsigned)b), hi = __builtin_amdgcn_readfirstlane((unsigned)(b >> 32));
    return __builtin_amdgcn_make_buffer_rsrc((void*)(((unsigned long long)hi << 32) | lo), 0, nbytes, 0x00020000); }
#ifndef MK_M3_LD_AUX
#define MK_M3_LD_AUX 2
#endif
template <int AUX = 0> __device__ __forceinline__ v4u bld128(rsrc_t rs, unsigned voff, unsigned soff) { return __builtin_amdgcn_raw_buffer_load_b128(rs, voff, soff, AUX); }
__device__ __forceinline__ u32x2 bld64(rsrc_t rs, unsigned voff, unsigned soff) { return __builtin_amdgcn_raw_buffer_load_b64(rs, voff, soff, 0); }
__device__ __forceinline__ void bst64(u32x2 v, rsrc_t rs, unsigned voff, unsigned soff) { __builtin_amdgcn_raw_buffer_store_b64(v, rs, voff, soff, 0); }
__device__ __forceinline__ int unit_of(int dir, int cg, int h) { return (dir * NCHUNK + cg) * 4 + h; }

struct Ctx {
    LAS unsigned char* lds; int tid, lane, wave, G, bid;
    const float *x_prompt, *x_sample, *norm_mix_g, *w_in, *gate_b, *conv_w, *conv_norm_g, *mlstm_norm_g, *w_out, *norm_ffn_g, *w_up, *ffn_conv_w, *ffn_conv_b, *w_down, *final_norm_g;
    float* out; unsigned char* ws;
};

#ifndef MK_X0_F32
#define MK_X0_F32 1
#endif
__device__ __forceinline__ void phase_x0(const Ctx& C) {
    int tid_ = C.tid; asm volatile("" : "+v"(tid_)); const int lane_ = tid_ & 63;
    const int gw = C.bid * 8 + C.wave, NGW = C.G * 8;
    bf16* xl = (bf16*)(C.ws + WS_X); bf16* xh = (bf16*)(C.ws + WS_XB); float* ps0 = (float*)(C.ws + WS_PS);
    f32x4 v[8];
    if (gw < T) { const float* src = gw < 16384 ? C.x_prompt + (size_t)gw * D : C.x_sample + (size_t)(gw - 16384) * D; const f32x4* s4 = (const f32x4*)src + lane_;
#pragma unroll
        for (int j = 0; j < 8; ++j) v[j] = s4[64 * j]; }
    for (int r = gw; r < T; r += NGW) {
        f32x4 vn[8]; const int rn = r + NGW;
        if (rn < T) { const float* src = rn < 16384 ? C.x_prompt + (size_t)rn * D : C.x_sample + (size_t)(rn - 16384) * D; const f32x4* s4 = (const f32x4*)src + lane_;
#pragma unroll
            for (int j = 0; j < 8; ++j) vn[j] = s4[64 * j]; }
        float ss = 0.f;
#pragma unroll
        for (int j = 0; j < 8; ++j) ss += (v[j][0] * v[j][0] + v[j][1] * v[j][1]) + (v[j][2] * v[j][2] + v[j][3] * v[j][3]);
        ss = wave_sum(ss);
        u32x2* h2 = (u32x2*)(xh + (size_t)r * D) + lane_; u32x2* l2 = (u32x2*)(xl + (size_t)r * D) + lane_;
#pragma unroll
        for (int j = 0; j < 8; ++j) { u32x2 wh; wh.x = pkbf(v[j][0], v[j][1]); wh.y = pkbf(v[j][2], v[j][3]);
            u32x2 wl; wl.x = pkbf(v[j][0] - __uint_as_float(wh.x << 16), v[j][1] - __uint_as_float(wh.x & 0xffff0000u)); wl.y = pkbf(v[j][2] - __uint_as_float(wh.y << 16), v[j][3] - __uint_as_float(wh.y & 0xffff0000u));
            h2[64 * j] = wh; if (MK_RESID_LO && !MK_X0_F32) l2[64 * j] = wl; }
        if (lane_ < 32) ps0[(size_t)r * 32 + lane_] = lane_ == 0 ? ss : 0.f;
        if (rn < T) {
#pragma unroll
            for (int j = 0; j < 8; ++j) v[j] = vn[j]; }
    }
}

__device__ __forceinline__ void tr_item(const float* W, int K, int Npad, int Nsrc, bf16* WT, const float* gain, int qlo, int qhi, bool permup, bool permin, LAS float* scr, int item, int lane) {
    const int nblk = Npad / 32, kb = item / nblk, nb = item % nblk, k0 = 64 * kb, n0 = 32 * nb;
    const int t_ = (n0 - 1024) & 255, pnp_ = (n0 - 1024) >> 8;
    const int n = (permup ? ((n0 >> 7) & 1) * DFF + 128 * (n0 >> 8) + (n0 & 127) : (permin && n0 >= 1024 && n0 < 3072) ? (((t_ >> 5) & 1) ? 2048 : 1024) + 128 * pnp_ + 32 * (t_ >> 6) + (t_ & 31) : n0) + (lane & 31); const float cs = (n >= qlo && n < qhi) ? 0.0625f : 1.0f;
    float wv[32];
#pragma unroll
    for (int i = 0; i < 32; ++i) { const int kk = 2 * i + (lane >> 5); wv[i] = (n < Nsrc) ? __builtin_nontemporal_load(W + (size_t)(k0 + kk) * Nsrc + n) : 0.f; }
#pragma unroll
    for (int i = 0; i < 32; ++i) { const int kk = 2 * i + (lane >> 5); float w = wv[i]; if (gain) w *= gain[k0 + kk]; scr[kk * 33 + (lane & 31)] = w * cs; }
    asm volatile("s_waitcnt lgkmcnt(0)" ::: "memory");
    const int c = lane & 7;
#pragma unroll
    for (int j = 0; j < 4; ++j) { const int nn = (lane >> 3) + 8 * j; const LAS float* s = scr + (8 * c) * 33 + nn;
        v4u o; o.x = pkbf(s[0 * 33], s[1 * 33]); o.y = pkbf(s[2 * 33], s[3 * 33]); o.z = pkbf(s[4 * 33], s[5 * 33]); o.w = pkbf(s[6 * 33], s[7 * 33]);
        __builtin_nontemporal_store(o, (v4u*)(WT + (size_t)(n0 + nn) * K + k0 + 8 * c)); }
    asm volatile("s_waitcnt lgkmcnt(0)" ::: "memory");
}
__device__ __forceinline__ void phase_w(const Ctx& C, int l, int part = 0) {
    int tid_ = C.tid; asm volatile("" : "+v"(tid_)); const int lane_ = tid_ & 63; (void)lane_;
    LAS float* scr = (LAS float*)(C.lds + C.wave * 16384);
    if (part == 1 && C.bid < 128) return;
    const int gw = (part == 1 ? C.bid - 128 : C.bid) * 8 + C.wave, NGW = (part == 1 ? 128 : C.G) * 8;
    constexpr int I_IN = (D / 64) * (NINP / 32), I_OUT = (D / 64) * (D / 32), I_UP = (D / 64) * (NUP / 32), I_DOWN = (DFF / 64) * (D / 32);
    constexpr int NITEMS = I_IN + I_OUT + I_UP + I_DOWN;
    bf16* wb = (bf16*)(C.ws + WS_W + (size_t)(l & 1) * W_BUF);
    constexpr int W_SPLIT = (NITEMS * 11 / 20) & ~7;
    const int it_lo = part == 2 ? W_SPLIT : 0, it_hi = part == 1 ? W_SPLIT : NITEMS;
    for (int it = it_lo + gw; it < it_hi; it += NGW) {
        int r = it;
        if (r < I_IN) { tr_item(C.w_in + (size_t)l * D * NIN, D, NINP, NIN, (bf16*)((unsigned char*)wb + WO_IN), C.norm_mix_g + l * D, 3072, 4096, false, true, scr, r, lane_); continue; } r -= I_IN;
        if (r < I_OUT) { tr_item(C.w_out + (size_t)l * D * D, D, D, D, (bf16*)((unsigned char*)wb + WO_OUT), nullptr, 0, 0, false, false, scr, r, lane_); continue; } r -= I_OUT;
        if (r < I_UP) { tr_item(C.w_up + (size_t)l * D * NUP, D, NUP, NUP, (bf16*)((unsigned char*)wb + WO_UP), C.norm_ffn_g + l * D, 0, 0, true, false, scr, r, lane_); continue; } r -= I_UP;
        tr_item(C.w_down + (size_t)l * DFF * D, DFF, D, D, (bf16*)((unsigned char*)wb + WO_DOWN), nullptr, 0, 0, false, false, scr, r, lane_);
    }
}

__device__ __forceinline__ void unpack8(const v4u& w, float (&f)[8]) {
    f[0] = __uint_as_float(w.x << 16); f[1] = __uint_as_float(w.x & 0xffff0000u); f[2] = __uint_as_float(w.y << 16); f[3] = __uint_as_float(w.y & 0xffff0000u);
    f[4] = __uint_as_float(w.z << 16); f[5] = __uint_as_float(w.z & 0xffff0000u); f[6] = __uint_as_float(w.w << 16); f[7] = __uint_as_float(w.w & 0xffff0000u);
}
constexpr int CV_T = 2;
__device__ __forceinline__ void conv_loads(const bf16* proj, int t0, int c0, v4u (&a)[CV_T + 2][2], v4u (&cbv)[CV_T][2]) {
    const int tlo = t0 < 16384 ? 0 : 16384 + ((t0 - 16384) & ~2047), thi = t0 < 16384 ? 16384 : tlo + 2048;
#pragma unroll
    for (int r = 0; r < CV_T + 2; ++r) { const int tt = t0 - 1 + r; const bool ok = tt >= tlo && tt < thi; const bf16* rp = proj + (size_t)(ok ? tt : t0) * PROJW + c0;
#pragma unroll
        for (int hh = 0; hh < 2; ++hh) { a[r][hh] = *(const v4u*)(rp + COL_P + 8 * hh); if (!ok) { a[r][hh].x = 0u; a[r][hh].y = 0u; a[r][hh].z = 0u; a[r][hh].w = 0u; } } }
#pragma unroll
    for (int k = 0; k < CV_T; ++k)
#pragma unroll
        for (int hh = 0; hh < 2; ++hh) cbv[k][hh] = *(const v4u*)(proj + (size_t)(t0 + k) * PROJW + c0 + 8 * hh);
}
__device__ __forceinline__ void phase_conv(const Ctx& C, int l, int b0, int nb) {
    int tid_ = C.tid; asm volatile("" : "+v"(tid_)); const int lane_ = tid_ & 63;
    if (C.bid < b0 || C.bid >= b0 + nb) return;
    const int gw = (C.bid - b0) * 8 + C.wave, NGW = nb * 8;
    const bf16* proj = (const bf16*)(C.ws + WS_PROJ); bf16* mix = (bf16*)(C.ws + WS_MIX);
    const float* cw = C.conv_w + (size_t)l * 3 * 1024; const float* cg = C.conv_norm_g + (size_t)l * 1024;
    const int c0 = 16 * lane_;
    v4u a[CV_T + 2][2], cbv[CV_T][2];
    if (gw < T / CV_T) conv_loads(proj, CV_T * gw, c0, a, cbv);
    f32x4 wv[3][4], g4[4];
#pragma unroll
    for (int q = 0; q < 4; ++q) { wv[0][q] = *(const f32x4*)(cw + c0 + 4 * q); wv[1][q] = *(const f32x4*)(cw + 1024 + c0 + 4 * q); wv[2][q] = *(const f32x4*)(cw + 2048 + c0 + 4 * q); g4[q] = *(const f32x4*)(cg + c0 + 4 * q); }
    for (int tg = gw; tg < T / CV_T; tg += NGW) {
        const int t0 = CV_T * tg;
        float y[CV_T][16];
#pragma unroll
        for (int hh = 0; hh < 2; ++hh) {
            const f32x4 w0a = wv[0][2 * hh], w0b = wv[0][2 * hh + 1], w1a = wv[1][2 * hh], w1b = wv[1][2 * hh + 1], w2a = wv[2][2 * hh], w2b = wv[2][2 * hh + 1];
            float p[CV_T + 2][8];
#pragma unroll
            for (int r = 0; r < CV_T + 2; ++r) unpack8(a[r][hh], p[r]);
#pragma unroll
            for (int k = 0; k < CV_T; ++k) { float fc[8]; unpack8(cbv[k][hh], fc);
#pragma unroll
                for (int i = 0; i < 8; ++i) { const float w0 = i < 4 ? w0a[i & 3] : w0b[i & 3], w1 = i < 4 ? w1a[i & 3] : w1b[i & 3], w2 = i < 4 ? w2a[i & 3] : w2b[i & 3];
                    y[k][8 * hh + i] = fc[i] * (w0 * p[k][i] + w1 * p[k + 1][i] + w2 * p[k + 2][i]); } }
        }
        if (tg + NGW < T / CV_T) conv_loads(proj, CV_T * (tg + NGW), c0, a, cbv);
#pragma unroll
        for (int k = 0; k < CV_T; ++k) {
            float ss = 0.f;
#pragma unroll
            for (int i = 0; i < 16; ++i) ss += y[k][i] * y[k][i];
            ss += __shfl_xor(ss, 1); ss += __shfl_xor(ss, 2); ss += __shfl_xor(ss, 4);
            const float rn = rsqrtf(ss * (1.0f / 128.0f) + EPS);
#pragma unroll
            for (int hh = 0; hh < 2; ++hh) { v4u o; float z[8];
#pragma unroll
                for (int i = 0; i < 8; ++i) z[i] = y[k][8 * hh + i] * rn * g4[2 * hh + (i >> 2)][i & 3];
                o.x = pkbf(z[0], z[1]); o.y = pkbf(z[2], z[3]); o.z = pkbf(z[4], z[5]); o.w = pkbf(z[6], z[7]);
                *(v4u*)(mix + (size_t)(t0 + k) * D + c0 + 8 * hh) = o; }
        }
    }
}

__device__ __forceinline__ void stage_tile(int tid, rsrc_t rsP, unsigned colbytes, LAS unsigned char* dst, const LAS float* rowscale, bool perm = false) {
    const int row0 = tid >> 5, c16 = tid & 31;
    const unsigned vo = (unsigned)(row0 * (PROJW * 2) + c16 * 16);
    LAS unsigned char* d0 = dst + row0 * TPITCH + (perm ? ((c16 >> 2) * 64 + (c16 & 3) * 8) : c16 * 16);
#pragma unroll
    for (int i = 0; i < 8; ++i) {
        v4u v = bld128(rsP, vo, colbytes + (unsigned)(i * 16 * PROJW * 2));
        if (rowscale) { float f[8]; unpack8(v, f); const float s = rowscale[row0 + 16 * i];
            v.x = pkbf(f[0] * s, f[1] * s); v.y = pkbf(f[2] * s, f[3] * s); v.z = pkbf(f[4] * s, f[5] * s); v.w = pkbf(f[6] * s, f[7] * s); }
        if (perm) { u32x2 lo, hi; lo.x = v.x; lo.y = v.y; hi.x = v.z; hi.y = v.w; *(LAS u32x2*)(d0 + i * 16 * TPITCH) = lo; *(LAS u32x2*)(d0 + i * 16 * TPITCH + 32) = hi; }
        else *(LAS v4u*)(d0 + i * 16 * TPITCH) = v;
        if (i == 3) __builtin_amdgcn_sched_barrier(0); }
}
__device__ __forceinline__ void bst128(v4u v, rsrc_t rs, unsigned voff, unsigned soff) { __builtin_amdgcn_raw_buffer_store_b128(v, rs, voff, soff, 0); }

template <int AUX = 0> __device__ __forceinline__ void tile_load(int tid, rsrc_t rsP, unsigned colbytes, v4u (&r)[8]) {
    const unsigned vo = (unsigned)((tid >> 5) * (PROJW * 2) + (tid & 31) * 16);
#pragma unroll
    for (int i = 0; i < 8; ++i) r[i] = bld128<AUX>(rsP, vo, colbytes + (unsigned)(i * 16 * PROJW * 2));
}
__device__ __forceinline__ void tile_write(int tid, LAS unsigned char* dst, const v4u (&r)[8], const LAS float* rowscale, bool perm) {
    const int row0 = tid >> 5, c16 = tid & 31;
    LAS unsigned char* d0 = dst + row0 * TPITCH + (perm ? ((c16 >> 2) * 64 + (c16 & 3) * 8) : c16 * 16);
#pragma unroll
    for (int i = 0; i < 8; ++i) { v4u v = r[i];
        if (rowscale) { float f[8]; unpack8(v, f); const float sc = rowscale[row0 + 16 * i];
            v.x = pkbf(f[0] * sc, f[1] * sc); v.y = pkbf(f[2] * sc, f[3] * sc); v.z = pkbf(f[4] * sc, f[5] * sc); v.w = pkbf(f[6] * sc, f[7] * sc); }
        if (perm) { u32x2 lo, hi; lo.x = v.x; lo.y = v.y; hi.x = v.z; hi.y = v.w; *(LAS u32x2*)(d0 + i * 16 * TPITCH) = lo; *(LAS u32x2*)(d0 + i * 16 * TPITCH + 32) = hi; }
        else *(LAS v4u*)(d0 + i * 16 * TPITCH) = v; }
}
__device__ __forceinline__ void phase_m1(const Ctx& C) {
    const bf16* proj = (const bf16*)(C.ws + WS_PROJ); const float* gates = (const float*)(C.ws + WS_GATES);
    float* BQ = (float*)(C.ws + WS_BQ); float* BK = (float*)(C.ws + WS_BK); float* KMAX = (float*)(C.ws + WS_KMAX); float* BLAST = (float*)(C.ws + WS_BLAST); float* DN = (float*)(C.ws + WS_DN);
    bf16* S = (bf16*)(C.ws + WS_S);
    LAS unsigned char* VT = C.lds + VT_OFF; LAS unsigned char* KT = C.lds + KT_OFF; LAS float* SC = (LAS float*)(C.lds + SC_OFF);
    const int wave = C.wave;
    v4u vraw[8], kraw[8]; float ipn = 0.f, fpn = 0.f;
    if (C.bid < NCHUNK * 4) { int tid = C.tid; asm volatile("" : "+v"(tid)); const int cg = C.bid >> 2, h = C.bid & 3, t0 = cg * 128;
        const rsrc_t rsP = mkrsrc(proj + (size_t)t0 * PROJW, 128u * PROJW * 2u);
        tile_load(tid, rsP, (unsigned)((COL_V + 256 * h) * 2), vraw); tile_load(tid, rsP, (unsigned)((COL_K + 256 * h) * 2), kraw);
        if (tid < 256) { const float* gp = gates + (size_t)(t0 + (tid & 127)) * 16; const int dir = (tid >> 7) & 1; ipn = gp[8 * dir + h]; fpn = gp[8 * dir + 4 + h]; } }
    for (int un = C.bid; un < NCHUNK * 4; un += C.G) {
        int tid = C.tid; asm volatile("" : "+v"(tid));
        const int lane = tid & 63, fr = lane & 15, fq = lane >> 4, q4 = fr >> 2, p4 = fr & 3;
        const int cg = un >> 2, h = un & 3, t0 = cg * 128;
        const int dir = (tid >> 7) & 1, j = tid & 127;
        const float ip = ipn;
        __syncthreads();
        if (tid < 256) SC[tid] = fminf(fpn, 0.f) - log1pf(__expf(-fabsf(fpn)));
        tile_write(tid, VT, vraw, nullptr, false);
        __syncthreads();
        const float lfv = (tid < 256) ? SC[tid] : 0.f;
        float inc = lfv;
#pragma unroll
        for (int o = 1; o < 64; o <<= 1) { const float tpre = __shfl_up(inc, o); if (lane >= o) inc += tpre; }
        if (lane == 63 && wave < 4) SC[772 + wave] = inc;
        __syncthreads();
        float bqv = 0.f, bkv = -3.0e38f;
        if (tid < 256) { const float w0 = SC[772 + 2 * dir], w1 = SC[772 + 2 * dir + 1]; const float incl = inc + ((wave & 1) ? w0 : 0.f);
            bqv = dir == 0 ? incl : (w0 + w1) - incl + lfv; bkv = ip - bqv; }
        float mx = bkv;
#pragma unroll
        for (int o = 1; o < 64; o <<= 1) mx = fmaxf(mx, __shfl_xor(mx, o));
        if (lane == 0 && wave < 4) SC[768 + wave] = mx;
        __syncthreads();
        if (tid < 256) { const float kmax = fmaxf(SC[768 + 2 * dir], SC[768 + 2 * dir + 1]); SC[512 + tid] = __expf(bkv - kmax);
            BQ[(size_t)(dir * 4 + h) * T + t0 + j] = bqv; BK[(size_t)(dir * 4 + h) * T + t0 + j] = bkv;
            const int u = unit_of(dir, cg, h);
            if (j == 0) KMAX[u] = kmax;
            if ((dir == 0 && j == 127) || (dir == 1 && j == 0)) BLAST[u] = bqv; }
#pragma unroll
        for (int dd = 0; dd < 2; ++dd) {
            __syncthreads();
            tile_write(tid, KT, kraw, SC + 512 + dd * 128, true);
            __syncthreads();
            const int u = unit_of(dd, cg, h);
            if (tid < 256) { float s = 0.f;
#pragma unroll 1
                for (int r0 = 0; r0 < 128; r0 += 16) { unsigned x[16];
#pragma unroll
                    for (int i = 0; i < 16; ++i) x[i] = *(const LAS unsigned short*)(KT + (r0 + i) * TPITCH + 2 * tid);
                    asm volatile("s_waitcnt lgkmcnt(0)" : "+v"(x[0]), "+v"(x[1]), "+v"(x[2]), "+v"(x[3]), "+v"(x[4]), "+v"(x[5]), "+v"(x[6]), "+v"(x[7]), "+v"(x[8]), "+v"(x[9]), "+v"(x[10]), "+v"(x[11]), "+v"(x[12]), "+v"(x[13]), "+v"(x[14]), "+v"(x[15]));
#pragma unroll
                    for (int i = 0; i < 16; ++i) s += __uint_as_float(x[i] << 16); }
                DN[(size_t)u * 256 + (tid & ~31) + 8 * ((tid >> 2) & 3) + 4 * ((tid >> 4) & 1) + (tid & 3)] = s; }
            if (dd == 1 && un + C.G < NCHUNK * 4) {
                const int un2 = un + C.G, cg2 = un2 >> 2, h2 = un2 & 3, t02 = cg2 * 128;
                const rsrc_t rsP2 = mkrsrc(proj + (size_t)t02 * PROJW, 128u * PROJW * 2u);
                tile_load(tid, rsP2, (unsigned)((COL_V + 256 * h2) * 2), vraw); tile_load(tid, rsP2, (unsigned)((COL_K + 256 * h2) * 2), kraw);
                if (tid < 256) { const float* gp = gates + (size_t)(t02 + j) * 16; ipn = gp[8 * dir + h2]; fpn = gp[8 * dir + 4 + h2]; } }
            const rsrc_t rsS = mkrsrc(S + (size_t)u * 65536, 131072u);
            const unsigned sv = (unsigned)(fr * 512 + 16 * fq);
#pragma unroll
            for (int hb = 0; hb < 2; ++hb) {
                f32x4 acc[2][8];
#pragma unroll
                for (int a = 0; a < 2; ++a)
#pragma unroll
                    for (int b = 0; b < 8; ++b) acc[a][b] = (f32x4){0.f, 0.f, 0.f, 0.f};
#pragma unroll 1
                for (int ks = 0; ks < 4; ++ks) {
                    const int rb = (32 * ks + 8 * fq + q4) * TPITCH + 8 * p4;
                    bf16x8 vf[2];
#pragma unroll
                    for (int a = 0; a < 2; ++a) { const int eo = (32 * wave + 16 * a) * 2; vf[a] = cat8(tr16(VT + rb + eo), tr16(VT + rb + 4 * TPITCH + eo)); }
#pragma unroll
                    for (int b = 0; b < 8; ++b) { const bf16x8 kf = cat8(tr16(KT + rb + 32 * (8 * hb + b)), tr16(KT + rb + 4 * TPITCH + 32 * (8 * hb + b)));
#pragma unroll
                        for (int a = 0; a < 2; ++a) acc[a][b] = __builtin_amdgcn_mfma_f32_16x16x32_bf16(kf, vf[a], acc[a][b], 0, 0, 0); }
                }
#pragma unroll
                for (int a = 0; a < 2; ++a)
#pragma unroll
                    for (int b2 = 0; b2 < 4; ++b2) { v4u w; w.x = pkbf(acc[a][2 * b2][0], acc[a][2 * b2][1]); w.y = pkbf(acc[a][2 * b2][2], acc[a][2 * b2][3]); w.z = pkbf(acc[a][2 * b2 + 1][0], acc[a][2 * b2 + 1][1]); w.w = pkbf(acc[a][2 * b2 + 1][2], acc[a][2 * b2 + 1][3]);
                        bst128(w, rsS, sv + 64u * (4 * hb + b2), (unsigned)((32 * wave + 16 * a) * 512)); }
            }
        }
    }
}

__device__ __forceinline__ void phase_m2_generic(const Ctx& C) {
    const float* KMAX = (const float*)(C.ws + WS_KMAX); const float* BLAST = (const float*)(C.ws + WS_BLAST); float* DN = (float*)(C.ws + WS_DN); float* US = (float*)(C.ws + WS_US);
    bf16* S = (bf16*)(C.ws + WS_S);
    LAS float* SC = (LAS float*)(C.lds + SC_OFF);
    int tid = C.tid; asm volatile("" : "+v"(tid));
    constexpr int N_PM = 128, N_SM = 512, N_V = 40, N_ALL = N_PM + N_SM + N_V;
    const int nmine = C.G == 256 ? (C.bid < 128 ? (C.bid < N_V ? 2 : 1) : 4) : (N_ALL - C.bid + C.G - 1) / C.G;
    for (int k = 0; k < nmine; ++k) {
        const int it = C.G == 256 ? (C.bid < 128 ? (k == 0 ? C.bid : N_PM + N_SM + C.bid) : N_PM + 4 * (C.bid - 128) + k) : C.bid + k * C.G;
        int dir, seq, h, slab;
        if (it < N_PM) { dir = it >> 6; h = (it >> 4) & 3; slab = it & 15; seq = 0; }
        else if (it < N_PM + N_SM) { const int r = it - N_PM; dir = r >> 8; seq = 1 + ((r >> 6) & 3); h = (r >> 4) & 3; slab = r & 15; }
        else { const int r = it - N_PM - N_SM; dir = r / 20; const int sh = r % 20; seq = sh >> 2; h = sh & 3; slab = 16; }
        const int c0 = seq == 0 ? 0 : 128 + 16 * (seq - 1), nc = seq == 0 ? 128 : 16;
        __syncthreads();
        if (tid < nc) { const int cg = dir == 0 ? c0 + tid : c0 + nc - 1 - tid; const int u = unit_of(dir, cg, h); SC[tid] = KMAX[u]; SC[128 + tid] = BLAST[u]; }
        __syncthreads();
        if (tid == 0) { float m = 0.f;
            for (int c = 0; c < nc; c += 8) { float kx[8], bl[8];
#pragma unroll
                for (int i = 0; i < 8; ++i) { kx[i] = SC[c + i]; bl[i] = SC[128 + c + i]; }
#pragma unroll
                for (int i = 0; i < 8; ++i) { SC[256 + c + i] = m; m = bl[i] + fmaxf(m, kx[i]); } } }
        __syncthreads();
        if (tid < nc) { const float m = SC[256 + tid], kx = SC[tid], M = fmaxf(m, kx); SC[384 + tid] = __expf(m - M); SC[512 + tid] = __expf(kx - M);
            if (slab == 16) { const int cg = dir == 0 ? c0 + tid : c0 + nc - 1 - tid; float* us = US + (size_t)unit_of(dir, cg, h) * 4; us[0] = __expf(m - M); us[1] = __expf(kx - M); us[2] = M; us[3] = 0.f; } }
        __syncthreads();
        if (slab < 16) {
            float c8[8];
#pragma unroll
            for (int j = 0; j < 8; ++j) c8[j] = 0.f;
            const size_t eoff = (size_t)slab * 4096 + tid * 8;
            const int ustep = dir == 0 ? 4 : -4;
            bf16* p = S + (size_t)unit_of(dir, dir == 0 ? c0 : c0 + nc - 1, h) * 65536 + eoff;
            v4u d[16];
#pragma unroll
            for (int i = 0; i < 16; ++i) d[i] = __builtin_nontemporal_load((const v4u*)(p + (ptrdiff_t)(i * ustep) * 65536));
            for (int cb = 0; cb < nc; cb += 16) {
                v4u dn[16];
                const bool more = cb + 16 < nc;
                if (more) {
#pragma unroll
                    for (int i = 0; i < 16; ++i) dn[i] = __builtin_nontemporal_load((const v4u*)(p + (ptrdiff_t)((16 + i) * ustep) * 65536));
                }
#pragma unroll
                for (int i = 0; i < 16; ++i) { const float a = SC[384 + cb + i], b = SC[512 + cb + i];
                    v4u w; w.x = pkbf(c8[0], c8[1]); w.y = pkbf(c8[2], c8[3]); w.z = pkbf(c8[4], c8[5]); w.w = pkbf(c8[6], c8[7]);
                    *(v4u*)(p + (ptrdiff_t)(i * ustep) * 65536) = w;
                    float f[8]; unpack8(d[i], f);
#pragma unroll
                    for (int j = 0; j < 8; ++j) c8[j] = a * c8[j] + b * f[j]; }
                if (more) {
#pragma unroll
                    for (int i = 0; i < 16; ++i) d[i] = dn[i];
                }
                p += (ptrdiff_t)(16 * ustep) * 65536;
            }
        } else if (tid < 256) {
            float nv = 0.f;
            for (int c = 0; c < nc; ++c) { const int cg = dir == 0 ? c0 + c : c0 + nc - 1 - c; float* p = DN + (size_t)unit_of(dir, cg, h) * 256 + tid; const float dv = *p; *p = nv; nv = SC[384 + c] * nv + SC[512 + c] * dv; }
        }
    }
}

__device__ __forceinline__ void m2_decode_matrix(int it, bool prompt, int& dir, int& seq, int& h, int& slab) {
    if (prompt) { dir = it >> 7; h = (it >> 5) & 3; slab = it & 31; seq = 0; }
    else { dir = it >> 9; seq = 1 + ((it >> 7) & 3); h = (it >> 5) & 3; slab = it & 31; }
}
__device__ __forceinline__ void m2_stream(bf16* S, const LAS float* tab, int dir, int seq, int h, int slab, int t256) {
    const int c0 = seq == 0 ? 0 : 128 + 16 * (seq - 1), nc = seq == 0 ? 128 : 16;
    float c8[8];
#pragma unroll
    for (int j = 0; j < 8; ++j) c8[j] = 0.f;
    const int ustep = dir == 0 ? 4 : -4;
    bf16* p = S + (size_t)unit_of(dir, dir == 0 ? c0 : c0 + nc - 1, h) * 65536 + (size_t)slab * 2048 + t256 * 8;
    v4u d[16];
#pragma unroll
    for (int i = 0; i < 16; ++i) d[i] = __builtin_nontemporal_load((const v4u*)(p + (ptrdiff_t)(i * ustep) * 65536));
    for (int cb = 0; cb < nc; cb += 16) {
        v4u dn[16]; const bool more = cb + 16 < nc;
        if (more) {
#pragma unroll
            for (int i = 0; i < 16; ++i) dn[i] = __builtin_nontemporal_load((const v4u*)(p + (ptrdiff_t)((16 + i) * ustep) * 65536));
        }
#pragma unroll
        for (int i = 0; i < 16; ++i) { const float a = tab[384 + cb + i], b = tab[512 + cb + i];
            v4u w; w.x = pkbf(c8[0], c8[1]); w.y = pkbf(c8[2], c8[3]); w.z = pkbf(c8[4], c8[5]); w.w = pkbf(c8[6], c8[7]);
            *(v4u*)(p + (ptrdiff_t)(i * ustep) * 65536) = w;
            float f[8]; unpack8(d[i], f);
#pragma unroll
            for (int j = 0; j < 8; ++j) c8[j] = a * c8[j] + b * f[j]; }
        if (more) {
#pragma unroll
            for (int i = 0; i < 16; ++i) d[i] = dn[i];
        }
        p += (ptrdiff_t)(16 * ustep) * 65536;
    }
}
__device__ __forceinline__ void phase_m2(const Ctx& C) {
    if (C.G != 256) { phase_m2_generic(C); return; }
    const float* KMAX = (const float*)(C.ws + WS_KMAX); const float* BLAST = (const float*)(C.ws + WS_BLAST); float* DN = (float*)(C.ws + WS_DN); float* US = (float*)(C.ws + WS_US);
    bf16* S = (bf16*)(C.ws + WS_S);
    LAS float* SC = (LAS float*)(C.lds + SC_OFF);
    int tid = C.tid; asm volatile("" : "+v"(tid));
    const bool has_vec = C.bid < 40;
    __syncthreads();
#pragma unroll 1
    for (int t = 0; t < 6; ++t) {
        int dir, seq, h, slab;
        if (t == 0) m2_decode_matrix(C.bid, true, dir, seq, h, slab); else if (t < 5) m2_decode_matrix(4 * C.bid + t - 1, false, dir, seq, h, slab);
        else { if (!has_vec) break; dir = C.bid / 20; const int sh = C.bid % 20; seq = sh >> 2; h = sh & 3; }
        const int c0 = seq == 0 ? 0 : 128 + 16 * (seq - 1), nc = seq == 0 ? 128 : 16;
        if (tid < nc) { const int cg = dir == 0 ? c0 + tid : c0 + nc - 1 - tid; const int u = unit_of(dir, cg, h); SC[t * 640 + tid] = KMAX[u]; SC[t * 640 + 128 + tid] = BLAST[u]; }
    }
    __syncthreads();
    if (tid < 6 && (tid < 5 || has_vec)) { LAS float* tb = SC + tid * 640; const int nc = (tid == 0 || (tid == 5 && (C.bid % 20) < 4)) ? 128 : 16; float m = 0.f;
        for (int c = 0; c < nc; c += 8) { float kx[8], bl[8];
#pragma unroll
            for (int i = 0; i < 8; ++i) { kx[i] = tb[c + i]; bl[i] = tb[128 + c + i]; }
#pragma unroll
            for (int i = 0; i < 8; ++i) { tb[256 + c + i] = m; m = bl[i] + fmaxf(m, kx[i]); } } }
    __syncthreads();
#pragma unroll 1
    for (int t = 0; t < 6; ++t) {
        if (t == 5 && !has_vec) break;
        const int nc = (t == 0 || (t == 5 && (C.bid % 20) < 4)) ? 128 : 16;
        if (tid < nc) { LAS float* tb = SC + t * 640; const float m = tb[256 + tid], kx = tb[tid], M = fmaxf(m, kx); tb[384 + tid] = __expf(m - M); tb[512 + tid] = __expf(kx - M);
            if (t == 5) { const int dir = C.bid / 20, sh = C.bid % 20, seq = sh >> 2, h = sh & 3; const int c0 = seq == 0 ? 0 : 128 + 16 * (seq - 1);
                const int cg = dir == 0 ? c0 + tid : c0 + nc - 1 - tid; float* us = US + (size_t)unit_of(dir, cg, h) * 4; us[0] = __expf(m - M); us[1] = __expf(kx - M); us[2] = M; us[3] = 0.f; } }
    }
    __syncthreads();
    if (tid < 256) { int dir, seq, h, slab; m2_decode_matrix(C.bid, true, dir, seq, h, slab); m2_stream(S, SC, dir, seq, h, slab, tid); }
    else {
        const int t2 = tid - 256;
#pragma unroll 1
        for (int k = 0; k < 4; ++k) { int dir, seq, h, slab; m2_decode_matrix(4 * C.bid + k, false, dir, seq, h, slab); m2_stream(S, SC + (1 + k) * 640, dir, seq, h, slab, t2); }
        if (has_vec) { const int dir = C.bid / 20, sh = C.bid % 20, seq = sh >> 2, h = sh & 3; const int c0 = seq == 0 ? 0 : 128 + 16 * (seq - 1), nc = seq == 0 ? 128 : 16;
            const LAS float* tb = SC + 5 * 640; float nv = 0.f;
            for (int c = 0; c < nc; ++c) { const int cg = dir == 0 ? c0 + c : c0 + nc - 1 - c; float* p = DN + (size_t)unit_of(dir, cg, h) * 256 + t2; const float dv = *p; *p = nv; nv = tb[384 + c] * nv + tb[512 + c] * dv; } }
    }
}

__device__ __forceinline__ void m3_fetch(const Ctx& C, int l, int tid, int wave, int un, v4u (&vraw)[8], v4u (&kraw)[8], float (&scn)[3]) {
    const bf16* proj = (const bf16*)(C.ws + WS_PROJ); const float* BK = (const float*)(C.ws + WS_BK); const float* KMAX = (const float*)(C.ws + WS_KMAX); const float* DN = (const float*)(C.ws + WS_DN);
    const int cg = un >> 2, h = un & 3, t0 = cg * 128; (void)wave;
    const rsrc_t rsP = mkrsrc(proj + (size_t)t0 * PROJW, 128u * PROJW * 2u);
    tile_load<MK_M3_LD_AUX>(tid, rsP, (unsigned)((COL_V + 256 * h) * 2), vraw); tile_load<MK_M3_LD_AUX>(tid, rsP, (unsigned)((COL_K + 256 * h) * 2), kraw);
    const int dd = tid >> 8, ix = tid & 255, ud = unit_of(dd, cg, h);
    scn[0] = DN[(size_t)ud * 256 + ix];
    scn[1] = ix < 128 ? __expf(BK[(size_t)(dd * 4 + h) * T + t0 + ix] - KMAX[ud]) : 0.f;
    scn[2] = dd == 0 ? C.mlstm_norm_g[(size_t)l * 1024 + 256 * h + ix] : 0.f;
}
__device__ __forceinline__ void phase_m3(const Ctx& C, int l, unsigned long long* tm = nullptr) {
    const bf16* proj = (const bf16*)(C.ws + WS_PROJ); bf16* mix = (bf16*)(C.ws + WS_MIX);
    const float* BQ = (const float*)(C.ws + WS_BQ);
    const float* US = (const float*)(C.ws + WS_US); const bf16* S = (const bf16*)(C.ws + WS_S);
    LAS unsigned char* VT = C.lds + VT_OFF; LAS unsigned char* KT = C.lds + KT_OFF; LAS float* SC = (LAS float*)(C.lds + SC_OFF);
    const int wave = C.wave;
    v4u vraw[8], kraw[8]; float scn[3] = {0.f, 0.f, 0.f};
    if (C.bid < NCHUNK * 4) { int tid = C.tid; asm volatile("" : "+v"(tid)); m3_fetch(C, l, tid, wave, C.bid, vraw, kraw, scn); }
    for (int un = C.bid; un < NCHUNK * 4; un += C.G) {
        int tid = C.tid; asm volatile("" : "+v"(tid));
        const int lane = tid & 63, fr = lane & 15, fq = lane >> 4, q4 = fr >> 2, p4 = fr & 3;
        const int cg = un >> 2, h = un & 3, t0 = cg * 128, tl = 16 * wave + fr, t = t0 + tl;
        const rsrc_t rsP = mkrsrc(proj + (size_t)t0 * PROJW, 128u * PROJW * 2u);
        const unsigned pv = (unsigned)(tl * (PROJW * 2));
        unsigned long long tq0 = 0ull; if (tm) tq0 = __builtin_amdgcn_s_memrealtime();
        __syncthreads();
        bf16x8 qf[8];
#pragma unroll
        for (int ks = 0; ks < 8; ++ks) qf[ks] = __builtin_bit_cast(bf16x8, bld128<MK_M3_LD_AUX>(rsP, pv + 16u * fq + 64u * ks, (unsigned)((COL_Q + 256 * h) * 2)));
        { const int dd = tid >> 8, ix = tid & 255;
          SC[256 * dd + ix] = scn[0];
          if (ix < 128) SC[512 + 128 * dd + ix] = scn[1];
          if (dd == 0) SC[768 + ix] = scn[2]; }
        tile_write(tid, VT, vraw, nullptr, true);
        tile_write(tid, KT, kraw, nullptr, false);
        bf16x8 pf[2][4]; float al[2], inv[2];
        __syncthreads();
        if (tm) { const unsigned long long t_ = __builtin_amdgcn_s_memrealtime(); tm[0] += t_ - tq0; tq0 = t_; }
#pragma unroll
        for (int dir = 0; dir < 2; ++dir) {
            const int u = unit_of(dir, cg, h);
            const float be = US[(size_t)u * 4 + 1], MM = US[(size_t)u * 4 + 2], bqt = BQ[(size_t)(dir * 4 + h) * T + t];
            al[dir] = US[(size_t)u * 4];
            const LAS float* nv = SC + 256 * dir; const LAS float* wkv = SC + 512 + 128 * dir;
            float qn = 0.f;
#pragma unroll
            for (int ks = 0; ks < 8; ++ks) {
                const f32x4 n0 = *(const LAS f32x4*)(nv + 32 * ks + 8 * fq), n1 = *(const LAS f32x4*)(nv + 32 * ks + 8 * fq + 4);
#pragma unroll
                for (int j = 0; j < 4; ++j) qn += bf2f((unsigned short)qf[ks][j]) * n0[j] + bf2f((unsigned short)qf[ks][4 + j]) * n1[j];
                __builtin_amdgcn_sched_barrier(0);
            }
            qn += __shfl_xor(qn, 16); qn += __shfl_xor(qn, 32);
            float rsum = 0.f;
            const int sp_lo = dir == 0 ? 0 : (wave >> 1), sp_hi = dir == 0 ? (wave >> 1) : 3;
#pragma unroll
            for (int sp = 0; sp < 4; ++sp) {
                v4u pw; pw.x = 0u; pw.y = 0u; pw.z = 0u; pw.w = 0u;
                if (sp >= sp_lo && sp <= sp_hi) {
                    f32x4 st0 = (f32x4){0.f, 0.f, 0.f, 0.f}, st1 = (f32x4){0.f, 0.f, 0.f, 0.f};
                    LAS const unsigned char* kb = KT + (32 * sp + fr) * TPITCH + 16 * fq;
#pragma unroll
                    for (int ks = 0; ks < 8; ++ks) { const bf16x8 k0 = *(LAS const bf16x8*)(kb + 64 * ks), k1 = *(LAS const bf16x8*)(kb + 16 * TPITCH + 64 * ks);
                        st0 = __builtin_amdgcn_mfma_f32_16x16x32_bf16(k0, qf[ks], st0, 0, 0, 0); st1 = __builtin_amdgcn_mfma_f32_16x16x32_bf16(k1, qf[ks], st1, 0, 0, 0);
                        if ((ks & 3) == 3) __builtin_amdgcn_sched_barrier(0); }
                    const f32x4 wk0 = *(const LAS f32x4*)(wkv + 32 * sp + 4 * fq) * be, wk1 = *(const LAS f32x4*)(wkv + 32 * sp + 16 + 4 * fq) * be;
                    int tlx = tl - 4 * fq; asm volatile("" : "+v"(tlx));
#pragma unroll
                    for (int jj = 0; jj < 4; ++jj) { const int s0 = 32 * sp + jj, s1 = s0 + 16;
                        const bool k0 = dir == 0 ? (s0 <= tlx) : (s0 >= tlx), k1 = dir == 0 ? (s1 <= tlx) : (s1 >= tlx);
                        st0[jj] = k0 ? st0[jj] * wk0[jj] : 0.f; st1[jj] = k1 ? st1[jj] * wk1[jj] : 0.f; rsum += st0[jj] + st1[jj]; }
                    pw.x = pkbf(st0[0], st0[1]); pw.y = pkbf(st0[2], st0[3]); pw.z = pkbf(st1[0], st1[1]); pw.w = pkbf(st1[2], st1[3]);
                }
                pf[dir][sp] = __builtin_bit_cast(bf16x8, pw);
            }
            rsum += __shfl_xor(rsum, 16); rsum += __shfl_xor(rsum, 32);
            const float den = al[dir] * qn + rsum, lower = __expf(-bqt - MM);
            inv[dir] = __builtin_amdgcn_rcpf(fmaxf(fabsf(den), lower));
        }
        __syncthreads();
        if (tm) { const unsigned long long t_ = __builtin_amdgcn_s_memrealtime(); tm[1] += t_ - tq0; tq0 = t_; }
        f32x4 hs[16];
        const int dl = lane & 31, dh = lane >> 5;
#define M3_ISSUE(sl) do { const bf16* src_ = S + (size_t)unit_of((sl) & 1, cg, h) * 65536 + (size_t)(64 * ((sl) >> 1)) * 256; \
            _Pragma("unroll") for (int i_ = 0; i_ < 4; ++i_) { const int row_ = 2 * (4 * wave + i_) + dh; \
                const int erow_ = 32 * (row_ >> 5) + 8 * ((row_ & 15) >> 2) + 4 * ((row_ >> 4) & 1) + (row_ & 3);     \
                __builtin_amdgcn_global_load_lds((const unsigned*)(src_ + (size_t)erow_ * 256 + ((dl ^ (row_ & 15)) * 8)), (LAS unsigned*)(KT + ((sl) & 1) * 32768 + (4 * wave + i_) * 1024), 16, 0, 0); } } while (0)
        M3_ISSUE(0);
#pragma unroll
        for (int sl = 0; sl < 8; ++sl) {
            const int qt = sl >> 1, dir = sl & 1;
            asm volatile("s_waitcnt vmcnt(0)" ::: "memory"); __builtin_amdgcn_s_barrier(); asm volatile("" ::: "memory");
            if (sl + 1 < 8) M3_ISSUE(sl + 1);
            const int sp_lo = dir == 0 ? 0 : (wave >> 1), sp_hi = dir == 0 ? (wave >> 1) : 3;
            LAS const unsigned char* cb = KT + (sl & 1) * 32768 + fr * 512;
            f32x4 acc[4];
#pragma unroll
            for (int e4 = 0; e4 < 4; ++e4) acc[e4] = (f32x4){0.f, 0.f, 0.f, 0.f};
#pragma unroll
            for (int ks = 0; ks < 8; ++ks) {
                const int ch = ((4 * ks + fq) ^ fr) * 16;
                bf16x8 cf[4];
#pragma unroll
                for (int e4 = 0; e4 < 4; ++e4) cf[e4] = *(LAS const bf16x8*)(cb + e4 * 8192 + ch);
                asm volatile("" : "+v"(cf[0]), "+v"(cf[1]), "+v"(cf[2]), "+v"(cf[3]));
#pragma unroll
                for (int e4 = 0; e4 < 4; ++e4) acc[e4] = __builtin_amdgcn_mfma_f32_16x16x32_bf16(cf[e4], qf[ks], acc[e4], 0, 0, 0);
            }
#pragma unroll
            for (int e4 = 0; e4 < 4; ++e4) acc[e4] = acc[e4] * al[dir];
#pragma unroll
            for (int sp = 0; sp < 4; ++sp) {
                if (sp >= sp_lo && sp <= sp_hi) {
                    LAS const unsigned char* vb = VT + (32 * sp + 4 * fq + q4) * TPITCH + 8 * p4 + 32 * 4 * qt;
#pragma unroll
                    for (int e4 = 0; e4 < 4; ++e4) { const bf16x8 vf = cat8(tr16(vb + 32 * e4), tr16(vb + 16 * TPITCH + 32 * e4)); acc[e4] = __builtin_amdgcn_mfma_f32_16x16x32_bf16(vf, pf[dir][sp], acc[e4], 0, 0, 0); }
                }
            }
#pragma unroll
            for (int e4 = 0; e4 < 4; ++e4) { if (dir == 0) hs[4 * qt + e4] = acc[e4] * inv[0]; else hs[4 * qt + e4] += acc[e4] * inv[1]; }
        }
#undef M3_ISSUE
        if (tm) { const unsigned long long t_ = __builtin_amdgcn_s_memrealtime(); tm[2] += t_ - tq0; tq0 = t_; }
        v4u owv[8];
#pragma unroll
        for (int i = 0; i < 8; ++i) owv[i] = bld128<MK_M3_LD_AUX>(rsP, pv + 16u * fq + 64u * i, (unsigned)((COL_O + 256 * h) * 2));
        float ss = 0.f;
#pragma unroll
        for (int eb = 0; eb < 16; ++eb) ss += (hs[eb][0] * hs[eb][0] + hs[eb][1] * hs[eb][1]) + (hs[eb][2] * hs[eb][2] + hs[eb][3] * hs[eb][3]);
        ss += __shfl_xor(ss, 16); ss += __shfl_xor(ss, 32);
        const float rn = rsqrtf(ss * (1.0f / 256.0f) + EPS);
        v4u yk[8];
#pragma unroll
        for (int i = 0; i < 8; ++i) { const f32x4 ga = *(const LAS f32x4*)(SC + 768 + 32 * i + 8 * fq), gb = *(const LAS f32x4*)(SC + 768 + 32 * i + 8 * fq + 4);
            float o[8]; unpack8(owv[i], o); float y[8];
#pragma unroll
            for (int j = 0; j < 4; ++j) { y[j] = hs[2 * i][j] * rn * ga[j] * __builtin_amdgcn_rcpf(1.0f + __expf(-o[j])); y[4 + j] = hs[2 * i + 1][j] * rn * gb[j] * __builtin_amdgcn_rcpf(1.0f + __expf(-o[4 + j])); }
            yk[i].x = pkbf(y[0], y[1]); yk[i].y = pkbf(y[2], y[3]); yk[i].z = pkbf(y[4], y[5]); yk[i].w = pkbf(y[6], y[7]); }
        asm volatile("" ::: "memory");
        { int tf = C.tid; asm volatile("" : "+v"(tf));
          m3_fetch(C, l, tf, wave, (un + C.G < NCHUNK * 4) ? un + C.G : un, vraw, kraw, scn); }
        const rsrc_t rsM = mkrsrc(mix + (size_t)t0 * D, 128u * D * 2u);
#pragma unroll
        for (int i = 0; i < 8; ++i) bst128(yk[i], rsM, (unsigned)(tl * (D * 2)) + 16u * fq + 64u * i, (unsigned)((1024 + 256 * h) * 2));
        if (tm) { const unsigned long long t_ = __builtin_amdgcn_s_memrealtime(); tm[3] += t_ - tq0; }
    }
}

__device__ __forceinline__ void glufix_row(const Ctx& C, int l, int tid_, int row, const float* hm, const float* h0, const float* hp) {
    const float* fw = C.ffn_conv_w + (size_t)l * 3 * NUP; const float* fb = C.ffn_conv_b + (size_t)l * NUP; bf16* act = (bf16*)(C.ws + WS_ACT);
    for (int f = 4 * tid_; f < DFF; f += 4 * 512) {
        const f32x4 w0g = *(const f32x4*)(fw + f), w1g = *(const f32x4*)(fw + NUP + f), w2g = *(const f32x4*)(fw + 2 * NUP + f), bg = *(const f32x4*)(fb + f);
        const f32x4 w0v = *(const f32x4*)(fw + DFF + f), w1v = *(const f32x4*)(fw + NUP + DFF + f), w2v = *(const f32x4*)(fw + 2 * NUP + DFF + f), bv = *(const f32x4*)(fb + DFF + f);
        const f32x4 ag = *(const f32x4*)(hm + f), av = *(const f32x4*)(hm + DFF + f), bgv = *(const f32x4*)(h0 + f), bvv = *(const f32x4*)(h0 + DFF + f), cg4 = *(const f32x4*)(hp + f), cv4 = *(const f32x4*)(hp + DFF + f);
        float z[4];
#pragma unroll
        for (int j = 0; j < 4; ++j) { const float g = bg[j] + w0g[j] * ag[j] + w1g[j] * bgv[j] + w2g[j] * cg4[j], vv = bv[j] + w0v[j] * av[j] + w1v[j] * bvv[j] + w2v[j] * cv4[j];
            z[j] = g * __builtin_amdgcn_rcpf(1.0f + __expf(-g)) * vv; }
        u32x2 w; w.x = pkbf(z[0], z[1]); w.y = pkbf(z[2], z[3]);
        *(u32x2*)(act + (size_t)row * DFF + f) = w;
    }
}
__device__ __forceinline__ bool seq_start_panel(int pm) { return pm == 0 || pm == 64 || (pm > 64 && ((pm - 64) & 7) == 0); }
__device__ __forceinline__ void glufix_panel(const Ctx& C, int l, int tid_, int pm) {
    const float* HB = (const float*)(C.ws + WS_HB);
    if (!seq_start_panel(pm)) glufix_row(C, l, tid_, 256 * pm, HB + (size_t)((pm - 1) * 4 + 3) * NUP, HB + (size_t)(pm * 4 + 0) * NUP, HB + (size_t)(pm * 4 + 1) * NUP);
    if (pm + 1 < 96 && !seq_start_panel(pm + 1)) glufix_row(C, l, tid_, 256 * pm + 255, HB + (size_t)(pm * 4 + 2) * NUP, HB + (size_t)(pm * 4 + 3) * NUP, HB + (size_t)((pm + 1) * 4 + 0) * NUP);
}

#ifndef MK_LAST_LO
#define MK_LAST_LO 0
#endif
__device__ __forceinline__ void phase_final(const Ctx& C) {
    int tid_ = C.tid; asm volatile("" : "+v"(tid_)); const int lane_ = tid_ & 63;
    const int gw = C.bid * 8 + C.wave, NGW = C.G * 8;
    const bf16* xl = (const bf16*)(C.ws + WS_X); const bf16* xh = (const bf16*)(C.ws + WS_XB);
    const f32x4* g4 = (const f32x4*)C.final_norm_g + lane_;
    u32x2 a[8], b[8];
    if (gw < T) { const u32x2* h2 = (const u32x2*)(xh + (size_t)gw * D) + lane_; const u32x2* l2 = (const u32x2*)(xl + (size_t)gw * D) + lane_;
#pragma unroll
        for (int j = 0; j < 8; ++j) { a[j] = h2[64 * j]; if (MK_RESID_LO && MK_LAST_LO) b[j] = l2[64 * j]; else { b[j].x = 0u; b[j].y = 0u; } } }
    for (int r = gw; r < T; r += NGW) {
        u32x2 an[8], bn[8]; const int rn = r + NGW;
        if (rn < T) { const u32x2* h2 = (const u32x2*)(xh + (size_t)rn * D) + lane_; const u32x2* l2 = (const u32x2*)(xl + (size_t)rn * D) + lane_;
#pragma unroll
            for (int j = 0; j < 8; ++j) { an[j] = h2[64 * j]; if (MK_RESID_LO && MK_LAST_LO) bn[j] = l2[64 * j]; else { bn[j].x = 0u; bn[j].y = 0u; } } }
        f32x4* d4 = (f32x4*)(C.out + (size_t)r * D) + lane_;
        f32x4 v[8]; float ss = 0.f;
#pragma unroll
        for (int j = 0; j < 8; ++j) {
            v[j][0] = __uint_as_float(a[j].x << 16) + __uint_as_float(b[j].x << 16); v[j][1] = __uint_as_float(a[j].x & 0xffff0000u) + __uint_as_float(b[j].x & 0xffff0000u);
            v[j][2] = __uint_as_float(a[j].y << 16) + __uint_as_float(b[j].y << 16); v[j][3] = __uint_as_float(a[j].y & 0xffff0000u) + __uint_as_float(b[j].y & 0xffff0000u);
            ss += (v[j][0] * v[j][0] + v[j][1] * v[j][1]) + (v[j][2] * v[j][2] + v[j][3] * v[j][3]); }
        const float rs = rsqrtf(wave_sum(ss) * (1.0f / 2048.0f) + EPS);
#pragma unroll
        for (int j = 0; j < 8; ++j) d4[64 * j] = v[j] * rs * g4[64 * j];
        if (rn < T) {
#pragma unroll
            for (int j = 0; j < 8; ++j) { a[j] = an[j]; b[j] = bn[j]; } }
    }
}

template <class Sched> __device__ __forceinline__ pg8::RsTab rs_table_fill(const Ctx& C, const Sched& S, const float* ps) {
    pg8::RsTab rt; rt.tab = (LAS const float*)(C.lds + RST_OFF); rt.pm0 = rt.pm1 = rt.pm2 = rt.pm3 = -1; rt.ps = ps;
    pg8::Unit uu;
    for (int i = 0; S.next(i, uu); ++i) { const int p = uu.pm;
        if (p == rt.pm0 || p == rt.pm1 || p == rt.pm2 || p == rt.pm3) continue;
        if (rt.pm0 < 0) rt.pm0 = p; else if (rt.pm1 < 0) rt.pm1 = p; else if (rt.pm2 < 0) rt.pm2 = p; else if (rt.pm3 < 0) rt.pm3 = p; }
    int tid_ = C.tid; asm volatile("" : "+v"(tid_));
    LAS float* tab = (LAS float*)(C.lds + RST_OFF);
    if (tid_ < 256) {
        if (rt.pm0 >= 0) tab[tid_] = pg8::rstd_of_row(ps + (size_t)(rt.pm0 * 256 + tid_) * 32);
        if (rt.pm1 >= 0) tab[256 + tid_] = pg8::rstd_of_row(ps + (size_t)(rt.pm1 * 256 + tid_) * 32);
        if (rt.pm2 >= 0) tab[512 + tid_] = pg8::rstd_of_row(ps + (size_t)(rt.pm2 * 256 + tid_) * 32);
        if (rt.pm3 >= 0) tab[768 + tid_] = pg8::rstd_of_row(ps + (size_t)(rt.pm3 * 256 + tid_) * 32);
    }
    __syncthreads();
    return rt;
}

#ifndef MK_STAG
#define MK_STAG 0
#endif
#ifndef MK_W2_AFTER_M3
#define MK_W2_AFTER_M3 1
#endif
#ifndef MK_CONV_AFTER_M3
#define MK_CONV_AFTER_M3 1
#endif
#ifndef MK_P7_WGM
#define MK_P7_WGM 4
#endif
#ifndef MK_P5_WGM
#define MK_P5_WGM 4
#endif
#ifndef MK_P1_WGM
#define MK_P1_WGM 4
#endif
__device__ __forceinline__ void stagger(const Ctx& C, unsigned ticks) {
    if (!MK_STAG) return;
    if (C.bid & 1) {
#pragma unroll 1
        for (unsigned i = 0; i < ticks / 128u; ++i) __builtin_amdgcn_s_sleep(39);
    }
}

constexpr int N_PHASES = 30;
#ifndef MK_REP_X0
#define MK_REP_X0 0
#endif
#ifndef MK_REP_FIN
#define MK_REP_FIN 0
#endif
#ifndef MK_TIME_PHASE
#define MK_TIME_PHASE -1
#endif
#ifndef MK_REP_V1
#define MK_REP_V1 0
#endif
#ifndef MK_REP_V4
#define MK_REP_V4 0
#endif
#ifndef MK_XBAR
#define MK_XBAR 0
#endif
#ifndef MK_ONE_LAUNCH
#define MK_ONE_LAUNCH 1
#endif
struct Args { const float* in[15]; float* out; unsigned char* ws; int ph_lo, ph_hi, use_bar, pad; };
__global__ void __launch_bounds__(512, 2) mk_fwd(Args args) {
    extern __shared__ __attribute__((aligned(16))) unsigned char lds[];
    Ctx C;
    C.lds = (LAS unsigned char*)lds; C.tid = threadIdx.x; C.lane = C.tid & 63; C.wave = __builtin_amdgcn_readfirstlane(C.tid >> 6); C.G = gridDim.x; C.bid = blockIdx.x;
    C.x_prompt = args.in[0]; C.x_sample = args.in[1]; C.norm_mix_g = args.in[2]; C.w_in = args.in[3]; C.gate_b = args.in[4]; C.conv_w = args.in[5]; C.conv_norm_g = args.in[6]; C.mlstm_norm_g = args.in[7];
    C.w_out = args.in[8]; C.norm_ffn_g = args.in[9]; C.w_up = args.in[10]; C.ffn_conv_w = args.in[11]; C.ffn_conv_b = args.in[12]; C.w_down = args.in[13]; C.final_norm_g = args.in[14];
    C.out = args.out; C.ws = args.ws;
    volatile LAS unsigned* MISC = (volatile LAS unsigned*)(C.lds + MISC_OFF);
    if (C.tid < 64) MISC[C.tid] = 0u;
    __syncthreads();
    unsigned* barw = (unsigned*)(C.ws + WS_CTL) + CW_BAR;
    XcdBarrier bar; bar.bar = barw; bar.x = 0; bar.st = nullptr;
    if (args.use_bar) bar = xcd_barrier_post(barw, MISC + 8);
    const int lo = args.ph_lo, hi = args.ph_hi;
#define IN(k) (lo <= (k) && (k) < hi)
    unsigned long long tacc = 0ull, tph0 = 0ull; unsigned long long tm3[4] = {0ull, 0ull, 0ull, 0ull}; unsigned long long tim1[3] = {0ull, 0ull, 0ull}, tim5[3] = {0ull, 0ull, 0ull}, tim4[3] = {0ull, 0ull, 0ull}, tim7[3] = {0ull, 0ull, 0ull};
#define TBEG(k) do { if (MK_TIME_PHASE == (k)) tph0 = __builtin_amdgcn_s_memrealtime(); } while (0)
#define TEND(k) do { if (MK_TIME_PHASE == (k)) tacc += __builtin_amdgcn_s_memrealtime() - tph0; } while (0)
#define SEAM(k) do { if (IN((k) + 1)) xcd_barrier(bar); } while (0)
    float* SS = (float*)(C.ws + WS_PS);
    bf16* XB = (bf16*)(C.ws + WS_XB);
    if (IN(0)) { for (int rep = 0; rep <= 4 * MK_REP_X0; ++rep) phase_x0(C); phase_w(C, 0); SEAM(0); }
#pragma unroll 1
    for (int l = 0; l < DEPTH; ++l) {
        const int pb = 1 + 7 * l;
        const unsigned char* W = C.ws + WS_W + (size_t)(l & 1) * W_BUF;
        if (IN(pb + 0)) { TBEG(0);
            pg8::Gemm g{XB, (const bf16*)(W + WO_IN), T, NINP, D}; pg8::StaticOrder S; S.init(T, NINP, C.G, C.bid, MK_P1_WGM);
            stagger(C, 1000);
            pg8::EpiProj E{(bf16*)(C.ws + WS_PROJ), (float*)(C.ws + WS_GATES), rs_table_fill(C, S, SS + (size_t)(2 * l) * T * 32), C.gate_b + l * 16};
            pg8::gemm_phase<pg8::EpiProj, pg8::StaticOrder, true, true>(C.lds, g, S, E, (MK_TIME_PHASE == 10 || MK_TIME_PHASE == 11) ? tim1 : nullptr);
            SEAM(pb + 0); TEND(0);
        }
        if (IN(pb + 1)) { TBEG(1); TBEG(40); phase_m1(C); __syncthreads(); TEND(40); TBEG(41); if (l + 1 < DEPTH && !(MK_W2_AFTER_M3 && C.G == 256)) phase_w(C, l + 1, C.G == 256 ? 2 : 0); TEND(41); SEAM(pb + 1); TEND(1); }
        if (IN(pb + 2)) { TBEG(2); TBEG(30); TBEG(31); phase_m2(C); TEND(30); TEND(31); TBEG(32); if (!MK_CONV_AFTER_M3) phase_conv(C, l, 0, C.G); TEND(32); SEAM(pb + 2); TEND(2); }
        if (IN(pb + 3)) { TBEG(3); phase_m3(C, l, (MK_TIME_PHASE >= 50 && MK_TIME_PHASE <= 53) ? tm3 : nullptr); if (MK_CONV_AFTER_M3) phase_conv(C, l, 0, C.G); if (MK_W2_AFTER_M3 && l + 1 < DEPTH && C.G == 256) { __syncthreads(); phase_w(C, l + 1, 2); }         for (int xb_ = 0; xb_ < MK_XBAR; ++xb_) xcd_barrier(bar); SEAM(pb + 3); TEND(3); }
        if (IN(pb + 4)) { TBEG(4);
            pg8::Gemm g{(const bf16*)(C.ws + WS_MIX), (const bf16*)(W + WO_OUT), T, D, D}; pg8::StaticOrder S; S.init(T, D, C.G, C.bid, MK_P7_WGM);
            pg8::EpiResid E{XB, (bf16*)(C.ws + WS_X), SS + (size_t)(2 * l + 1) * T * 32, 1.f, 1, MK_RESID_LO != 0, MK_RESID_LO == 1, (MK_X0_F32 && l == 0) ? C.x_prompt : nullptr, C.x_sample};
            pg8::gemm_phase<pg8::EpiResid, pg8::StaticOrder, true, true>(C.lds, g, S, E, (MK_TIME_PHASE == 14 || MK_TIME_PHASE == 15) ? tim4 : nullptr);
            SEAM(pb + 4); TEND(4);
        }
        if (IN(pb + 5)) { TBEG(5);
            pg8::Gemm g{XB, (const bf16*)(W + WO_UP), T, NUP, D}; pg8::StaticOrder S; S.init(T, NUP, C.G, C.bid, MK_P5_WGM);
            stagger(C, 1000);
            pg8::EpiGlu E{(bf16*)(C.ws + WS_ACT), (float*)(C.ws + WS_HB), rs_table_fill(C, S, SS + (size_t)(2 * l + 1) * T * 32), C.ffn_conv_w + (size_t)l * 3 * NUP, C.ffn_conv_b + (size_t)l * NUP, C.lds + HALO_OFF};
            pg8::gemm_phase<pg8::EpiGlu, pg8::StaticOrder, true, true>(C.lds, g, S, E, (MK_TIME_PHASE == 12 || MK_TIME_PHASE == 13) ? tim5 : nullptr);
            if (l + 1 < DEPTH && C.G == 256) phase_w(C, l + 1, 1);
            SEAM(pb + 5); TEND(5);
        }
        if (IN(pb + 6)) { TBEG(6);
            pg8::Gemm g{(const bf16*)(C.ws + WS_ACT), (const bf16*)(W + WO_DOWN), T, D, DFF}; pg8::StaticOrder S; S.init(T, D, C.G, C.bid, MK_P7_WGM);
            { int tid_ = C.tid; asm volatile("" : "+v"(tid_)); pg8::Unit uu; int last_pm = -1;
              for (int i = 0; S.next(i, uu); ++i) { if (uu.pm != last_pm) glufix_panel(C, l, tid_, uu.pm); last_pm = uu.pm; }
              asm volatile("s_waitcnt vmcnt(0)" ::: "memory"); __syncthreads(); }
            pg8::EpiResid E{XB, (bf16*)(C.ws + WS_X), SS + (size_t)(2 * l + 2) * T * 32, 1.f, 1, MK_RESID_LO == 1, MK_RESID_LO != 0 && (MK_LAST_LO || l + 1 < DEPTH), nullptr, nullptr};
            pg8::gemm_phase<pg8::EpiResid, pg8::StaticOrder, true, true>(C.lds, g, S, E, (MK_TIME_PHASE == 16 || MK_TIME_PHASE == 17) ? tim7 : nullptr);
            SEAM(pb + 6); TEND(6);
        }
    }
    if (IN(29)) { for (int rep = 0; rep <= 4 * MK_REP_FIN; ++rep) phase_final(C); }
    if (MK_TIME_PHASE == 10) tacc = tim1[1]; if (MK_TIME_PHASE == 11) tacc = tim1[0]; if (MK_TIME_PHASE == 12) tacc = tim5[1]; if (MK_TIME_PHASE == 13) tacc = tim5[0]; if (MK_TIME_PHASE >= 50 && MK_TIME_PHASE <= 53) tacc = tm3[MK_TIME_PHASE - 50]; if (MK_TIME_PHASE == 14) tacc = tim4[1]; if (MK_TIME_PHASE == 15) tacc = tim4[0]; if (MK_TIME_PHASE == 16) tacc = tim7[1]; if (MK_TIME_PHASE == 17) tacc = tim7[0];
    if (MK_TIME_PHASE == 20) { const unsigned xcc = xb_xcc_id(); if (xcc != (blockIdx.x & 7u)) { const unsigned long long t0 = __builtin_amdgcn_s_memrealtime(); while (__builtin_amdgcn_s_memrealtime() - t0 < 100000ull) __builtin_amdgcn_s_sleep(8); } }
    if (MK_TIME_PHASE >= 0 && MK_TIME_PHASE != 20 && blockIdx.x == ((MK_TIME_PHASE == 31 || MK_TIME_PHASE == 32) ? 255u : 0u)) { const unsigned long long t0 = __builtin_amdgcn_s_memrealtime(); while (__builtin_amdgcn_s_memrealtime() - t0 < tacc) __builtin_amdgcn_s_sleep(8); }
#undef IN
#undef SEAM
}

extern "C" void kernel_launch(void* const* d_in, const int* in_sizes, int n_in, void* d_out, int out_size, void* d_ws, size_t ws_size, hipStream_t stream) {
    static int grid = 0;
    if (grid == 0) {
        if (n_in != 15 || out_size != T * D || ws_size < WS_END) { fprintf(stderr, "kernel_launch: unexpected shapes (n_in %d, out %d, ws %zu < %zu); nothing launched\n", n_in, out_size, ws_size, (size_t)WS_END); grid = -1; return; }
        int dev = 0, cus = 0, per_cu = 0;
        if (hipGetDevice(&dev) != hipSuccess || hipDeviceGetAttribute(&cus, hipDeviceAttributeMultiprocessorCount, dev) != hipSuccess) { grid = -1; return; }
        if (hipFuncSetAttribute((const void*)mk_fwd, hipFuncAttributeMaxDynamicSharedMemorySize, LDS_BYTES) != hipSuccess) { fprintf(stderr, "kernel_launch: hipFuncSetAttribute failed\n"); grid = -1; return; }
        if (hipOccupancyMaxActiveBlocksPerMultiprocessor(&per_cu, (const void*)mk_fwd, 512, LDS_BYTES) != hipSuccess || per_cu < 1) { fprintf(stderr, "kernel_launch: occupancy query says %d blocks per CU\n", per_cu); }
        (void)hipGetLastError();
        grid = cus;
    }
    if (grid < 0) return;
    (void)hipMemsetAsync((char*)d_ws + WS_CTL, 0, CTL_ZERO_BYTES, stream);
    Args a{};
    for (int i = 0; i < 15; ++i) a.in[i] = (const float*)d_in[i];
    a.out = (float*)d_out; a.ws = (unsigned char*)d_ws;
#if MK_ONE_LAUNCH
    a.ph_lo = 0; a.ph_hi = N_PHASES; a.use_bar = 1;
    hipLaunchKernelGGL(mk_fwd, dim3(grid), dim3(512), LDS_BYTES, stream, a);
#else
    for (int p = 0; p < N_PHASES; ++p) { a.ph_lo = p; a.ph_hi = p + 1; a.use_bar = 0; hipLaunchKernelGGL(mk_fwd, dim3(grid), dim3(512), LDS_BYTES, stream, a); }
#endif
}
```
